# Optimizing an MI355X kernel written in HIP

```python
import jax, jax.numpy as jnp
from jax import lax
import numpy as np

D_MODEL = 2048
BATCH = 4
SEQ = 4096
DEPTH = 2

PLE_DIM = 256
MIX_WIDTH = D_MODEL
HGRN_WIDTH = MIX_WIDTH // 2
GLA_WIDTH = MIX_WIDTH - HGRN_WIDTH
HGRN_HEAD_DIM = 128
HGRN_HEADS = HGRN_WIDTH // HGRN_HEAD_DIM
GLA_HEADS = 4
GLA_KEY_WIDTH = GLA_WIDTH // 2
GLA_HEAD_K = GLA_KEY_WIDTH // GLA_HEADS
GLA_HEAD_V = GLA_WIDTH // GLA_HEADS
GLA_GATE_RANK = 16
GLA_GATE_TEMP = 16.0
CHUNK = 64
FFN_DIM = 5632
N_EXPERTS = 8
TOP_K = 2
EXPERT_FFN_DIM = 7168
MOE_BLOCK = 512
EPS = 1e-6
N_DENSE = (DEPTH + 1) // 2
N_MOE = DEPTH // 2
IN_SIZES = (HGRN_WIDTH, HGRN_WIDTH, HGRN_WIDTH, HGRN_WIDTH,
            GLA_KEY_WIDTH, GLA_KEY_WIDTH, GLA_WIDTH, GLA_GATE_RANK, GLA_WIDTH)
IN_COLS = sum(IN_SIZES)
IN_SPLITS = tuple(int(s) for s in np.cumsum(IN_SIZES)[:-1])

kernel_name = 'hymba_hgrn2_gla_moe_ple_trunk'


def rms_norm(x, w):
    xf = x.astype(jnp.float32)
    y = xf * lax.rsqrt(jnp.mean(xf * xf, axis=-1, keepdims=True) + EPS)
    return (y * w.astype(jnp.float32)).astype(x.dtype)


def head_rms_norm(o, w):
    H, d = o.shape[-2], o.shape[-1]
    y = o * lax.rsqrt(jnp.mean(o * o, axis=-1, keepdims=True) + EPS)
    return y * w.astype(jnp.float32).reshape(H, d)


def chunk_gated_linear_attn(q, k, v, log_a):
    B, T, H, dk = q.shape
    dv = v.shape[-1]
    n = T // CHUNK

    def to_chunks(t):
        t = t.astype(jnp.float32)
        return t.reshape(B, n, CHUNK, H, t.shape[-1]).transpose(1, 0, 3, 2, 4)

    causal = jnp.tril(jnp.ones((CHUNK, CHUNK), dtype=bool))[:, :, None]

    def step(state, inp):
        qc, kc, vc, gc = inp
        g_cum = jnp.cumsum(gc, axis=2)
        diff = g_cum[:, :, :, None, :] - g_cum[:, :, None, :, :]
        decay = jnp.exp(jnp.where(causal, diff, -jnp.inf))
        scores = jnp.einsum('bhid,bhjd,bhijd->bhij', qc, kc, decay)
        out = (jnp.einsum('bhij,bhjv->bhiv', scores, vc)
               + jnp.einsum('bhid,bhdv->bhiv', qc * jnp.exp(g_cum), state))
        g_last = g_cum[:, :, -1, :]
        k_dec = kc * jnp.exp(g_last[:, :, None, :] - g_cum)
        state = jnp.exp(g_last)[..., None] * state + jnp.einsum('bhjd,bhjv->bhdv', k_dec, vc)
        return state, out

    s0 = jnp.zeros((B, H, dk, dv), jnp.float32)
    _, out = lax.scan(step, s0, (to_chunks(q), to_chunks(k), to_chunks(v), to_chunks(log_a)))
    return out.transpose(1, 0, 3, 2, 4).reshape(B, T, H, dv)


def hybrid_mixer(hn, w_in, lb, hgrn_norm_w, gla_w2, gla_b, gla_norm_w, w_out):
    B, T, _ = hn.shape
    proj = hn @ w_in
    hq, hf, hi, hg, gq, gk, gv, glr, gg = jnp.split(proj, IN_SPLITS, axis=-1)

    lbf = lb.astype(jnp.float32)
    log_f = jnp.logaddexp(jnp.log(lbf), jnp.log1p(-lbf) + jax.nn.log_sigmoid(hf.astype(jnp.float32)))
    k_h = -jnp.expm1(log_f)
    q_h = jax.nn.silu(hq)
    o_h = chunk_gated_linear_attn(q_h.reshape(B, T, HGRN_HEADS, HGRN_HEAD_DIM),
                                  k_h.reshape(B, T, HGRN_HEADS, HGRN_HEAD_DIM),
                                  hi.reshape(B, T, HGRN_HEADS, HGRN_HEAD_DIM),
                                  log_f.reshape(B, T, HGRN_HEADS, HGRN_HEAD_DIM))
    o_h = head_rms_norm(o_h, hgrn_norm_w) * jax.nn.sigmoid(
        hg.astype(jnp.float32)).reshape(B, T, HGRN_HEADS, HGRN_HEAD_DIM)

    log_a = jax.nn.log_sigmoid((glr @ gla_w2 + gla_b).astype(jnp.float32)) / GLA_GATE_TEMP
    o_g = chunk_gated_linear_attn((gq * (GLA_HEAD_K ** -0.5)).reshape(B, T, GLA_HEADS, GLA_HEAD_K),
                                  gk.reshape(B, T, GLA_HEADS, GLA_HEAD_K),
                                  gv.reshape(B, T, GLA_HEADS, GLA_HEAD_V),
                                  log_a.reshape(B, T, GLA_HEADS, GLA_HEAD_K))
    o_g = head_rms_norm(o_g, gla_norm_w) * jax.nn.silu(
        gg.astype(jnp.float32)).reshape(B, T, GLA_HEADS, GLA_HEAD_V)

    o = jnp.concatenate([o_h.reshape(B, T, HGRN_WIDTH), o_g.reshape(B, T, GLA_WIDTH)], axis=-1)
    return o.astype(hn.dtype) @ w_out


def swiglu(x, w_gate, w_up, w_down):
    return (jax.nn.silu(x @ w_gate) * (x @ w_up)) @ w_down


def moe_swiglu(hn, router_w, w_gate, w_up, w_down):
    B, T, D = hn.shape
    tokens = hn.reshape(-1, D)
    n = tokens.shape[0]
    logits = (tokens @ router_w).astype(jnp.float32)
    top_logit, top_e = lax.top_k(logits, TOP_K)
    top_w = jax.nn.softmax(top_logit, axis=-1)
    flat_e = top_e.reshape(-1)
    flat_tok = jnp.repeat(jnp.arange(n, dtype=jnp.int32), TOP_K)
    flat_w = top_w.reshape(-1)
    n_assign = n * TOP_K
    order = jnp.argsort(flat_e)
    sorted_e = flat_e[order]
    counts = jnp.bincount(flat_e, length=N_EXPERTS)
    padded = (counts + MOE_BLOCK - 1) // MOE_BLOCK * MOE_BLOCK
    padded_end = jnp.cumsum(padded)
    padded_start = padded_end - padded
    start = jnp.cumsum(counts) - counts
    dest = padded_start[sorted_e] + jnp.arange(n_assign, dtype=jnp.int32) - start[sorted_e]
    n_blocks = -(-n_assign // MOE_BLOCK) + N_EXPERTS
    cap = n_blocks * MOE_BLOCK
    slot_tok = jnp.full((cap,), n, jnp.int32).at[dest].set(flat_tok[order])
    slot_w = jnp.zeros((cap,), jnp.float32).at[dest].set(flat_w[order])
    block_e = jnp.minimum(jnp.searchsorted(padded_end, jnp.arange(n_blocks) * MOE_BLOCK, side='right'),
                          N_EXPERTS - 1)

    def run_block(args):
        tok_ids, e = args
        xb = jnp.take(tokens, tok_ids, axis=0, mode='clip')
        return swiglu(xb, w_gate[e], w_up[e], w_down[e])

    y = lax.map(run_block, (slot_tok.reshape(n_blocks, MOE_BLOCK), block_e))
    y = y.reshape(cap, D) * slot_w[:, None].astype(y.dtype)
    out = jnp.zeros_like(tokens).at[slot_tok].add(y, mode='drop')
    return out.reshape(B, T, D)


def setup_inputs(seed: int = 0) -> dict:
    key = jax.random.key(seed)
    ks = jax.random.split(key, 24)
    f32 = jnp.float32

    def nrm(k, shape, fan_in):
        return jax.random.normal(k, shape, f32) * (fan_in ** -0.5)

    def gain(k, shape):
        return 1.0 + 0.02 * jax.random.normal(k, shape, f32)

    return {
        'x': jax.random.normal(ks[0], (BATCH, SEQ, D_MODEL), f32),
        'p': jax.random.normal(ks[1], (DEPTH, BATCH, SEQ, PLE_DIM), f32),
        'norm_mix_w': gain(ks[2], (DEPTH, D_MODEL)),
        'w_in': nrm(ks[3], (DEPTH, D_MODEL, IN_COLS), D_MODEL),
        'hgrn_lb_logits': 0.5 * jax.random.normal(ks[4], (DEPTH, HGRN_WIDTH), f32),
        'hgrn_norm_w': gain(ks[5], (DEPTH, HGRN_WIDTH)),
        'gla_gate_w2': nrm(ks[6], (DEPTH, GLA_GATE_RANK, GLA_KEY_WIDTH), GLA_GATE_RANK),
        'gla_gate_b': 0.1 * jax.random.normal(ks[7], (DEPTH, GLA_KEY_WIDTH), f32),
        'gla_norm_w': gain(ks[8], (DEPTH, GLA_WIDTH)),
        'w_out': nrm(ks[9], (DEPTH, MIX_WIDTH, D_MODEL), MIX_WIDTH),
        'norm_ffn_w': gain(ks[10], (DEPTH, D_MODEL)),
        'dense_w_gate': nrm(ks[11], (N_DENSE, D_MODEL, FFN_DIM), D_MODEL),
        'dense_w_up': nrm(ks[12], (N_DENSE, D_MODEL, FFN_DIM), D_MODEL),
        'dense_w_down': nrm(ks[13], (N_DENSE, FFN_DIM, D_MODEL), FFN_DIM),
        'moe_router': nrm(ks[14], (N_MOE, D_MODEL, N_EXPERTS), D_MODEL),
        'moe_w_gate': nrm(ks[15], (N_MOE, N_EXPERTS, D_MODEL, EXPERT_FFN_DIM), D_MODEL),
        'moe_w_up': nrm(ks[16], (N_MOE, N_EXPERTS, D_MODEL, EXPERT_FFN_DIM), D_MODEL),
        'moe_w_down': nrm(ks[17], (N_MOE, N_EXPERTS, EXPERT_FFN_DIM, D_MODEL), EXPERT_FFN_DIM),
        'norm_ple_w': gain(ks[18], (DEPTH, D_MODEL)),
        'ple_w_gate': nrm(ks[19], (DEPTH, D_MODEL, D_MODEL), D_MODEL),
        'ple_w_proj': nrm(ks[20], (DEPTH, PLE_DIM, D_MODEL), PLE_DIM),
        'final_norm_w': gain(ks[21], (D_MODEL,)),
    }


def reference(x, p, norm_mix_w, w_in, hgrn_lb_logits, hgrn_norm_w, gla_gate_w2, gla_gate_b,
              gla_norm_w, w_out, norm_ffn_w, dense_w_gate, dense_w_up, dense_w_down,
              moe_router, moe_w_gate, moe_w_up, moe_w_down, norm_ple_w, ple_w_gate,
              ple_w_proj, final_norm_w):
    lbs = jnp.cumsum(jax.nn.softmax(hgrn_lb_logits.astype(jnp.float32), axis=0), axis=0)
    lbs = lbs - lbs[0]
    h = x
    for i in range(DEPTH):
        h = h + hybrid_mixer(rms_norm(h, norm_mix_w[i]), w_in[i], lbs[i], hgrn_norm_w[i],
                             gla_gate_w2[i], gla_gate_b[i], gla_norm_w[i], w_out[i])
        hn = rms_norm(h, norm_ffn_w[i])
        j = i // 2
        if i % 2 == 0:
            h = h + swiglu(hn, dense_w_gate[j], dense_w_up[j], dense_w_down[j])
        else:
            h = h + moe_swiglu(hn, moe_router[j], moe_w_gate[j], moe_w_up[j], moe_w_down[j])
        gate = jax.nn.sigmoid(rms_norm(h, norm_ple_w[i]) @ ple_w_gate[i])
        h = h + gate * (p[i] @ ple_w_proj[i])
    return rms_norm(h, final_norm_w)
```

```cpp
#include <hip/hip_runtime.h>
#include <cstdio>
#include <cstdint>
namespace pg8 {
#define PG8_LAS __attribute__((address_space(3)))
typedef unsigned short bf16_t;
typedef short bf16x8 __attribute__((ext_vector_type(8)));
typedef float f32x4 __attribute__((ext_vector_type(4)));
typedef unsigned u32x4 __attribute__((ext_vector_type(4)));
constexpr int BM = 256, BK = 64, HALF = 128, HTB = HALF * BK * 2  , STAGE_BYTES = 8 * HTB, NXCD = 8, WGM = 8;

__host__ __device__ __forceinline__ int lds_byte(int r, int c) { const int st = (r >> 4) * 2 + (c >> 5), rr = r & 15, cc = c & 31, ob = rr * 64 + cc * 2; return st * 1024 + (ob ^ (((ob >> 9) & 1) << 5)); }
__host__ __device__ __forceinline__ void stage_rc(int b, int& R, int& C) { const int st = b / 1024, sb = b % 1024, swz = sb ^ (((sb >> 9) & 1) << 5); R = (st >> 1) * 16 + swz / 64; C = (st & 1) * 32 + (swz % 64) / 2; }
__host__ __device__ __forceinline__ int perm32(int rho) { const int n = rho >> 4, i = rho & 15; return 8 * (i >> 2) + 4 * n + (i & 3); }

struct Unit { int pm, pn; };
struct Gemm { const bf16_t* A; const bf16_t* Bt; int M, N, K; };

struct StaticOrder {
    int nM, nN, nwg, G, c;
    __host__ __device__ void init(int M, int N, int G_, int c_) { nM = M / BM; nN = N / BM; nwg = nM * nN; G = G_; c = c_; }
    __host__ __device__ bool next(int i, Unit& u) const {
        const long L = (long)i * G + c; if (L >= nwg) return false;
        int wgid = (int)L; { const int q = nwg / NXCD, r = nwg % NXCD, xcd = wgid % NXCD, off = wgid / NXCD; wgid = (xcd < r ? xcd * (q + 1) : r * (q + 1) + (xcd - r) * q) + off; }
        const int nig = WGM * nN, gid = wgid / nig, fm = gid * WGM, gsz = (nM - fm) < WGM ? (nM - fm) : WGM;
        u.pm = fm + ((wgid % nig) % gsz); u.pn = (wgid % nig) / gsz; return true;
    }
    __device__ __forceinline__ void a_ready(const Unit&) const {}
    __device__ __forceinline__ void done(const Unit&) const {}
};

typedef int i32x4c __attribute__((ext_vector_type(4)));
typedef float f32x2c __attribute__((ext_vector_type(2)));
typedef __bf16 bf16x2c __attribute__((ext_vector_type(2)));
__device__ __forceinline__ unsigned cvt_pk_bf16(float lo, float hi) { const f32x2c v = {lo, hi}; const bf16x2c r = __builtin_convertvector(v, bf16x2c); return __builtin_bit_cast(unsigned, r); }
typedef float f32x2 __attribute__((ext_vector_type(2)));
__device__ __forceinline__ void glds16_s(const char* base, unsigned voff, unsigned lds_dst) {
    unsigned keep;
    asm volatile("s_mov_b32 %0, m0\n\ts_mov_b32 m0, %3\n\ts_nop 0\n\tglobal_load_lds_dwordx4 %1, %2\n\ts_mov_b32 m0, %0" : "=&s"(keep) : "v"(voff), "s"(base), "s"(lds_dst) : "memory");
}
__device__ __forceinline__ float ex(float x) { return __builtin_amdgcn_exp2f(x * 1.44269504089f); }
__device__ __forceinline__ float lg(float x) { return __log2f(x) * 0.69314718056f; }
__device__ __forceinline__ float sigm(float z) { return __builtin_amdgcn_rcpf(1.0f + ex(-z)); }
__device__ __forceinline__ float logsig(float z) { return fminf(z, 0.f) - lg(1.0f + ex(-fabsf(z))); }
__device__ __forceinline__ float bf_lo(unsigned u) { return __uint_as_float(u << 16); }
__device__ __forceinline__ float bf_hi(unsigned u) { return __uint_as_float(u & 0xffff0000u); }
typedef unsigned u32x2 __attribute__((ext_vector_type(2)));

__device__ __forceinline__ float rstd_of(const PG8_LAS float* rt, int rbase, int row) { return rt ? rt[row - rbase] : 1.0f; }
enum { TY_ID = 0, TY_SILU = 1, TY_SIG = 2, TY_SCALE = 3, TY_HF = 4, TY_LA = 5 };
struct EpiInProj {
    static constexpr bool PERM = true, AFTER_DRAIN = false;
    bf16_t *QH, *KH, *VH, *GATE, *QG, *KG, *VG; float *GH, *GG;
    const float *lb, *l1m, *gb;
    const PG8_LAS float* rt; int rbase;
    template <int TY> __device__ __forceinline__ void run(const f32x4 (&acc)[2][2][4][2], int row0, bf16_t* ob, float* of, int ld, int cb, int cc, int fq) const {
        float pa[2][8], pb[2][8];
#pragma unroll
        for (int bj = 0; bj < 2; ++bj)
#pragma unroll
            for (int i = 0; i < 8; ++i) { pa[bj][i] = 0.f; pb[bj][i] = 0.f;
                if (TY == TY_HF) { pa[bj][i] = lb[cc + bj * HALF + i]; pb[bj][i] = l1m[cc + bj * HALF + i]; }
                if (TY == TY_LA) { pa[bj][i] = gb[cc + bj * HALF + i]; } }
#pragma unroll
        for (int ai = 0; ai < 2; ++ai)
#pragma unroll
            for (int m = 0; m < 4; ++m) { const size_t ro = (size_t)(row0 + ai * HALF + m * 16) * ld + cb; const float rs_ = rstd_of(rt, rbase, row0 + ai * HALF + m * 16);
#pragma unroll
                for (int bj = 0; bj < 2; ++bj) { const f32x4 v0 = acc[ai][bj][m][0] * rs_, v1 = acc[ai][bj][m][1] * rs_;
                    float z[8] = {v0[0], v0[1], v0[2], v0[3], v1[0], v1[1], v1[2], v1[3]}; float y[8];
                    if (TY == TY_HF) { float lf[8];
#pragma unroll
                        for (int i = 0; i < 8; ++i) { const float a = pb[bj][i] + logsig(z[i]); lf[i] = pa[bj][i] > 0.f ? lg(pa[bj][i] + ex(a)) : a;
                            y[i] = (1.0f - pa[bj][i]) * __builtin_amdgcn_rcpf(1.0f + ex(z[i])); }
                        *(f32x4*)(of + ro + bj * HALF) = (f32x4){lf[0], lf[1], lf[2], lf[3]}; *(f32x4*)(of + ro + bj * HALF + 4) = (f32x4){lf[4], lf[5], lf[6], lf[7]};
                    } else if (TY == TY_LA) {
#pragma unroll
                        for (int i = 0; i < 8; ++i) y[i] = logsig(z[i] + pa[bj][i]) * 0.0625f;
                        *(f32x4*)(of + ro + bj * HALF) = (f32x4){y[0], y[1], y[2], y[3]}; *(f32x4*)(of + ro + bj * HALF + 4) = (f32x4){y[4], y[5], y[6], y[7]};
                    } else {
#pragma unroll
                        for (int i = 0; i < 8; ++i) { if (TY == TY_ID) y[i] = z[i]; if (TY == TY_SILU) y[i] = z[i] * sigm(z[i]); if (TY == TY_SIG) y[i] = sigm(z[i]); if (TY == TY_SCALE) y[i] = z[i] * 0.08838834764831845f; }
                    }
                    if (TY != TY_LA) { u32x4 w; w.x = cvt_pk_bf16(y[0], y[1]); w.y = cvt_pk_bf16(y[2], y[3]); w.z = cvt_pk_bf16(y[4], y[5]); w.w = cvt_pk_bf16(y[6], y[7]);
                        *(u32x4*)(ob + ro + bj * HALF) = w; } } }
    }
    __device__ __forceinline__ void operator()(const f32x4 (&acc)[2][2][4][2], const Unit& u, int wr, int wc, int fr, int fq) const {
        const int pn = u.pn, row0 = u.pm * BM + wr * 64 + fr, cw = wc * 32 + 8 * fq;
        if (pn < 4)       run<TY_SILU>(acc, row0, QH, nullptr, 1024, pn * 256 + cw, 0, fq);
        else if (pn < 8)  run<TY_HF>(acc, row0, KH, GH, 1024, (pn - 4) * 256 + cw, (pn - 4) * 256 + cw, fq);
        else if (pn < 12) run<TY_ID>(acc, row0, VH, nullptr, 1024, (pn - 8) * 256 + cw, 0, fq);
        else if (pn < 16) run<TY_SIG>(acc, row0, GATE, nullptr, 2048, (pn - 12) * 256 + cw, 0, fq);
        else if (pn < 18) run<TY_SCALE>(acc, row0, QG, nullptr, 512, (pn - 16) * 256 + cw, 0, fq);
        else if (pn < 20) run<TY_ID>(acc, row0, KG, nullptr, 512, (pn - 18) * 256 + cw, 0, fq);
        else if (pn < 24) run<TY_ID>(acc, row0, VG, nullptr, 1024, (pn - 20) * 256 + cw, 0, fq);
        else if (pn < 26) run<TY_LA>(acc, row0, nullptr, GG, 512, (pn - 24) * 256 + cw, (pn - 24) * 256 + cw, fq);
        else              run<TY_SILU>(acc, row0, GATE, nullptr, 2048, 1024 + (pn - 26) * 256 + cw, 0, fq);
    }
};
struct EpiPlainBf16 {
    static constexpr bool PERM = true, AFTER_DRAIN = false;
    bf16_t* O; int ldc;
    __device__ __forceinline__ void operator()(const f32x4 (&acc)[2][2][4][2], const Unit& u, int wr, int wc, int fr, int fq) const {
        const int row0 = u.pm * BM + wr * 64 + fr, col0 = u.pn * BM + wc * 32 + 8 * fq;
#pragma unroll
        for (int ai = 0; ai < 2; ++ai)
#pragma unroll
            for (int m = 0; m < 4; ++m) { bf16_t* rowp = O + (size_t)(row0 + ai * HALF + m * 16) * ldc + col0;
#pragma unroll
                for (int bj = 0; bj < 2; ++bj) { const f32x4 v0 = acc[ai][bj][m][0], v1 = acc[ai][bj][m][1];
                    u32x4 w; w.x = cvt_pk_bf16(v0[0], v0[1]); w.y = cvt_pk_bf16(v0[2], v0[3]); w.z = cvt_pk_bf16(v1[0], v1[1]); w.w = cvt_pk_bf16(v1[2], v1[3]);
                    *(u32x4*)(rowp + bj * HALF) = w; } }
    }
};
struct EpiSwiGLU {
    static constexpr bool PERM = true, AFTER_DRAIN = false;
    bf16_t* O; int ldc; int nNe; const PG8_LAS float* rt; int rbase;
    __device__ __forceinline__ void operator()(const f32x4 (&acc)[2][2][4][2], const Unit& u, int wr, int wc, int fr, int fq) const {
        const int pnl = u.pn - (u.pn / nNe) * nNe;
        const int row0 = u.pm * BM + wr * 64 + fr, col0 = pnl * HALF + wc * 32 + 8 * fq;
#pragma unroll
        for (int ai = 0; ai < 2; ++ai)
#pragma unroll
            for (int m = 0; m < 4; ++m) { bf16_t* rowp = O + (size_t)(row0 + ai * HALF + m * 16) * ldc + col0;
                const float rs_ = rstd_of(rt, rbase, row0 + ai * HALF + m * 16);
                const f32x4 g0 = acc[ai][0][m][0] * rs_, g1 = acc[ai][0][m][1] * rs_, u0 = acc[ai][1][m][0] * rs_, u1 = acc[ai][1][m][1] * rs_;
                float y[8];
#pragma unroll
                for (int i = 0; i < 4; ++i) { y[i] = g0[i] * sigm(g0[i]) * u0[i]; y[4 + i] = g1[i] * sigm(g1[i]) * u1[i]; }
                u32x4 w; w.x = cvt_pk_bf16(y[0], y[1]); w.y = cvt_pk_bf16(y[2], y[3]); w.z = cvt_pk_bf16(y[4], y[5]); w.w = cvt_pk_bf16(y[6], y[7]);
                *(u32x4*)rowp = w; }
    }
};
struct EpiResid {
    static constexpr bool PERM = false, AFTER_DRAIN = false;
    const float* base; float* out; int ldc; float sc; bf16_t* hb; float* rowss;
    __device__ __forceinline__ void operator()(const f32x4 (&acc)[2][2][4][2], const Unit& u, int wr, int wc, int fr, int fq) const {
        const int row0 = u.pm * BM + wr * 64 + fr, col0 = u.pn * BM + wc * 32 + 4 * fq;
        bf16_t* hb_ = hb; float* rss_ = rowss; asm volatile("" : "+s"(hb_), "+s"(rss_));
#pragma unroll
        for (int ai = 0; ai < 2; ++ai)
#pragma unroll
            for (int m = 0; m < 4; ++m) { const unsigned off = (unsigned)(row0 + ai * HALF + m * 16) * (unsigned)ldc + (unsigned)col0;
                f32x4 bs[2][2];
#pragma unroll
                for (int bj = 0; bj < 2; ++bj)
#pragma unroll
                    for (int n = 0; n < 2; ++n) bs[bj][n] = *(const f32x4*)(base + off + bj * HALF + n * 16);
                float ss = 0.f;
#pragma unroll
                for (int bj = 0; bj < 2; ++bj)
#pragma unroll
                    for (int n = 0; n < 2; ++n) { const f32x4 o = bs[bj][n] + acc[ai][bj][m][n] * sc; *(f32x4*)(out + off + bj * HALF + n * 16) = o;
                        if (hb_) { u32x2 w; w.x = cvt_pk_bf16(o[0], o[1]); w.y = cvt_pk_bf16(o[2], o[3]); *(u32x2*)(hb_ + off + bj * HALF + n * 16) = w; ss += (o[0] * o[0] + o[1] * o[1]) + (o[2] * o[2] + o[3] * o[3]); } }
                if (hb_) { ss += __shfl_xor(ss, 16); ss += __shfl_xor(ss, 32); if (fq == 0) rss_[(unsigned)(row0 + ai * HALF + m * 16) * 32u + (unsigned)(u.pn * 4 + wc)] = ss; }
                if (m & 1) asm volatile("" ::: "memory"); }
    }
};
struct EpiPle {
    static constexpr bool PERM = false, AFTER_DRAIN = false;
    float* H; const bf16_t* PP; int ldc; float sc; const PG8_LAS float* rt; int rbase; bf16_t* hb; float* rout;
    __device__ __forceinline__ void operator()(const f32x4 (&acc)[2][2][4][2], const Unit& u, int wr, int wc, int fr, int fq) const {
        const int row0 = u.pm * BM + wr * 64 + fr, col0 = u.pn * BM + wc * 32 + 4 * fq;
        bf16_t* hb_ = hb; float* rss_ = rout; asm volatile("" : "+s"(hb_), "+s"(rss_));
#pragma unroll
        for (int ai = 0; ai < 2; ++ai)
#pragma unroll
            for (int m = 0; m < 4; ++m) { const unsigned off = (unsigned)(row0 + ai * HALF + m * 16) * (unsigned)ldc + (unsigned)col0; const float rs_ = sc * rstd_of(rt, rbase, row0 + ai * HALF + m * 16);
                f32x4 bs[2][2]; u32x2 pp[2][2];
#pragma unroll
                for (int bj = 0; bj < 2; ++bj)
#pragma unroll
                    for (int n = 0; n < 2; ++n) { bs[bj][n] = *(const f32x4*)(H + off + bj * HALF + n * 16); pp[bj][n] = *(const u32x2*)(PP + off + bj * HALF + n * 16); }
                float ss = 0.f;
#pragma unroll
                for (int bj = 0; bj < 2; ++bj)
#pragma unroll
                    for (int n = 0; n < 2; ++n) { const f32x4 a = acc[ai][bj][m][n] * rs_; const u32x2 p = pp[bj][n];
                        f32x4 o = bs[bj][n]; o[0] += sigm(a[0]) * bf_lo(p.x); o[1] += sigm(a[1]) * bf_hi(p.x); o[2] += sigm(a[2]) * bf_lo(p.y); o[3] += sigm(a[3]) * bf_hi(p.y);
                        *(f32x4*)(H + off + bj * HALF + n * 16) = o;
                        if (hb_) { u32x2 w; w.x = cvt_pk_bf16(o[0], o[1]); w.y = cvt_pk_bf16(o[2], o[3]); *(u32x2*)(hb_ + off + bj * HALF + n * 16) = w; ss += (o[0] * o[0] + o[1] * o[1]) + (o[2] * o[2] + o[3] * o[3]); } }
                if (hb_) { ss += __shfl_xor(ss, 16); ss += __shfl_xor(ss, 32); if (fq == 0) rss_[(unsigned)(row0 + ai * HALF + m * 16) * 32u + (unsigned)(u.pn * 4 + wc)] = ss; }
                if (m & 1) asm volatile("" ::: "memory"); }
    }
};
struct EpiMoeDown {
    static constexpr bool PERM = true, AFTER_DRAIN = false;
    bf16_t* O; int ldc; int nNe; const float* sw; float sc;
    __device__ __forceinline__ void operator()(const f32x4 (&acc)[2][2][4][2], const Unit& u, int wr, int wc, int fr, int fq) const {
        const int pnl = u.pn - (u.pn / nNe) * nNe;
        const int row0 = u.pm * BM + wr * 64 + fr, col0 = pnl * BM + wc * 32 + 8 * fq;
#pragma unroll
        for (int ai = 0; ai < 2; ++ai)
#pragma unroll
            for (int m = 0; m < 4; ++m) { const int row = row0 + ai * HALF + m * 16; const float s = sw[row] * sc; bf16_t* rowp = O + (size_t)row * ldc + col0;
#pragma unroll
                for (int bj = 0; bj < 2; ++bj) { const f32x4 v0 = acc[ai][bj][m][0] * s, v1 = acc[ai][bj][m][1] * s;
                    u32x4 w; w.x = cvt_pk_bf16(v0[0], v0[1]); w.y = cvt_pk_bf16(v0[2], v0[3]); w.z = cvt_pk_bf16(v1[0], v1[1]); w.w = cvt_pk_bf16(v1[2], v1[3]);
                    *(u32x4*)(rowp + bj * HALF) = w; } }
    }
};
constexpr float F8_SA = 16.0f, F8_SWU = 256.0f, F8_SM = 4.0f, F8_SWD = 512.0f;
__device__ __forceinline__ float clamp8(float x) { return __builtin_amdgcn_fmed3f(x, -448.0f, 448.0f); }
__device__ __forceinline__ unsigned pk4_fp8(float a, float b, float c, float d) { int p = 0; p = __builtin_amdgcn_cvt_pk_fp8_f32(clamp8(a), clamp8(b), p, false); p = __builtin_amdgcn_cvt_pk_fp8_f32(clamp8(c), clamp8(d), p, true); return (unsigned)p; }
struct EpiSwiGLU8 {
    static constexpr bool PERM = true, AFTER_DRAIN = false;
    unsigned char* O; int ldc; int nNe; float sin, sout;
    __device__ __forceinline__ void operator()(const f32x4 (&acc)[2][2][4][2], const Unit& u, int wr, int wc, int fr, int fq) const {
        const int pnl = u.pn - (u.pn / nNe) * nNe;
        const int row0 = u.pm * BM + wr * 64 + fr, col0 = pnl * HALF + wc * 32 + 8 * fq;
#pragma unroll
        for (int ai = 0; ai < 2; ++ai)
#pragma unroll
            for (int m = 0; m < 4; ++m) { unsigned char* rowp = O + (size_t)(row0 + ai * HALF + m * 16) * ldc + col0;
                const f32x4 g0 = acc[ai][0][m][0] * sin, g1 = acc[ai][0][m][1] * sin, u0 = acc[ai][1][m][0] * sin, u1 = acc[ai][1][m][1] * sin;
                float y[8];
#pragma unroll
                for (int i = 0; i < 4; ++i) { y[i] = g0[i] * sigm(g0[i]) * u0[i] * sout; y[4 + i] = g1[i] * sigm(g1[i]) * u1[i] * sout; }
                u32x2 w; w.x = pk4_fp8(y[0], y[1], y[2], y[3]); w.y = pk4_fp8(y[4], y[5], y[6], y[7]);
                *(u32x2*)rowp = w; }
    }
};
struct MoeOrder {
    int nNe, G, c, P, nwg; int ps[9];
    __device__ __forceinline__ void init(const int* pstart, int nNe_, int G_, int c_) {
#pragma unroll
        for (int i = 0; i < 9; ++i) ps[i] = __builtin_amdgcn_readfirstlane(pstart[i]);
        nNe = nNe_; G = G_; c = c_; P = ps[8] / BM; nwg = P * nNe; }
    __device__ __forceinline__ bool next(int i, Unit& u) const {
        const long L = (long)i * G + c; if (L >= nwg) return false;
        int wgid = (int)L; { const int q = nwg / NXCD, r = nwg % NXCD, xcd = wgid % NXCD, off = wgid / NXCD; wgid = (xcd < r ? xcd * (q + 1) : r * (q + 1) + (xcd - r) * q) + off; }
        const int nig = WGM * nNe, gid = wgid / nig, fm = gid * WGM, gsz = (P - fm) < WGM ? (P - fm) : WGM;
        const int pm = fm + ((wgid % nig) % gsz), pnl = (wgid % nig) / gsz;
        int e = 0;
#pragma unroll
        for (int k = 1; k < 8; ++k) e += (pm * BM >= ps[k]) ? 1 : 0;
        u.pm = pm; u.pn = e * nNe + pnl; return true;
    }
    __device__ __forceinline__ void a_ready(const Unit&) const {}
    __device__ __forceinline__ void done(const Unit&) const {}
};


template <class Epi, class Sched, bool ALIGN_EPI = false, bool SP2 = false, bool F8 = false>
__device__ __forceinline__ void gemm_phase(PG8_LAS unsigned char* lds, const Gemm g, const Sched& S, const Epi& E) {
    int tid_ = threadIdx.x; asm volatile("" : "+v"(tid_));
    const int tid = tid_, wid = __builtin_amdgcn_readfirstlane(tid >> 6), lane = tid & 63, wr = wid >> 2, wc = wid & 3, fr = lane & 15, fq = lane >> 4;
    const int K = g.K, nt = K / BK;
    unsigned voffA[2], voffB[2];
#pragma unroll
    for (int i = 0; i < 2; ++i) { int R, C; stage_rc(tid * 16 + i * 8192, R, C); const int Rb = Epi::PERM ? ((R & ~31) + perm32(R & 31)) : R;
        voffA[i] = (unsigned)(R * K + C) * 2u; voffB[i] = (unsigned)(Rb * K + C) * 2u; }
    const size_t kstep = (size_t)(BK * 2);
    const size_t hstep = (size_t)HALF * K * 2;
    const size_t tstep = 2 * hstep;
    const unsigned ldsbase = (unsigned)(size_t)lds;
    const unsigned ldsw = (unsigned)wid * 1024u;
    const int aoff = lds_byte(wr * 64 + fr, fq * 8), boff = lds_byte(wc * 32 + fr, fq * 8);
#define PG8_SA(b, h) (((b) * 2 + (h)) * HTB)
#define PG8_SB(b, h) ((4 + (b) * 2 + (h)) * HTB)
#define PG8_STAGE(bufoff, gbase, voff) do { _Pragma("unroll") for (int _i = 0; _i < 2; ++_i) \
        glds16_s((const char*)(gbase), (voff)[_i], ldsbase + (unsigned)((bufoff) + _i * 8192) + ldsw); } while (0)
#define PG8_LDA(dst, b, h) do { _Pragma("unroll") for (int m = 0; m < 4; ++m) _Pragma("unroll") for (int k = 0; k < 2; ++k) dst[m][k] = *(const PG8_LAS bf16x8*)(lds + PG8_SA(b, h) + aoff + m * 2048 + k * 1024); } while (0)
#define PG8_LDB(dst, b, h) do { _Pragma("unroll") for (int n = 0; n < 2; ++n) _Pragma("unroll") for (int k = 0; k < 2; ++k) dst[n][k] = *(const PG8_LAS bf16x8*)(lds + PG8_SB(b, h) + boff + n * 2048 + k * 1024); } while (0)
#define PG8_CAT8(x, y) __builtin_shufflevector(__builtin_bit_cast(i32x4c, (x)), __builtin_bit_cast(i32x4c, (y)), 0, 1, 2, 3, 4, 5, 6, 7)
#define PG8_MMA(ai, bj, At, Bt) do { __builtin_amdgcn_s_setprio(1); \
        if constexpr (F8) { _Pragma("unroll") for (int m = 0; m < 4; ++m) _Pragma("unroll") for (int n = 0; n < 2; ++n) \
            asm volatile("v_mfma_scale_f32_16x16x128_f8f6f4 %0, %1, %2, %0, %3, %3 op_sel_hi:[0,0,0]" : "+v"(acc[ai][bj][m][n]) : "v"(PG8_CAT8(Bt[n][0], Bt[n][1])), "v"(PG8_CAT8(At[m][0], At[m][1])), "v"(sc7f)); } \
        else { _Pragma("unroll") for (int m = 0; m < 4; ++m) _Pragma("unroll") for (int n = 0; n < 2; ++n) _Pragma("unroll") for (int k = 0; k < 2; ++k) \
            acc[ai][bj][m][n] = __builtin_amdgcn_mfma_f32_16x16x32_bf16(Bt[n][k], At[m][k], acc[ai][bj][m][n], 0, 0, 0); } \
        __builtin_amdgcn_s_setprio(0); } while (0)
#define PG8_WAIT_V(n) asm volatile("s_waitcnt vmcnt(" #n ")" ::: "memory")
#define PG8_WAIT_L(n) asm volatile("s_waitcnt lgkmcnt(" #n ")" ::: "memory")
#define PG8_BAR __builtin_amdgcn_s_barrier()
#define PG8_SCHED __builtin_amdgcn_sched_barrier(0)
    int sc7f = 0x7F7F7F7F; asm volatile("" : "+v"(sc7f));
    Unit cur, nxt; int ui = 0;
    if (!S.next(0, cur)) return;
    f32x4 acc[2][2][4][2];
#pragma unroll
    for (int a = 0; a < 2; ++a)
#pragma unroll
        for (int b = 0; b < 2; ++b)
#pragma unroll
            for (int m = 0; m < 4; ++m)
#pragma unroll
                for (int n = 0; n < 2; ++n) acc[a][b][m][n] = (f32x4){0.f, 0.f, 0.f, 0.f};
    bf16x8 At[4][2], B0[2][2], B1[2][2];
    const char* cA = (const char*)g.A + (size_t)cur.pm * tstep; const char* cB = (const char*)g.Bt + (size_t)cur.pn * tstep;
    S.a_ready(cur);
    if constexpr (SP2) {
        PG8_STAGE(PG8_SB(0, 0), cB, voffB); PG8_STAGE(PG8_SB(0, 1), cB + hstep, voffB); PG8_STAGE(PG8_SA(0, 0), cA, voffA); PG8_STAGE(PG8_SA(0, 1), cA + hstep, voffA);
        if (wr == 1) PG8_BAR;
        PG8_WAIT_V(2); PG8_BAR;
        PG8_STAGE(PG8_SB(1, 0), cB + kstep, voffB); PG8_STAGE(PG8_SA(1, 0), cA + kstep, voffA); PG8_STAGE(PG8_SB(1, 1), cB + hstep + kstep, voffB);
        PG8_WAIT_V(6); PG8_BAR;
    } else {
        PG8_STAGE(PG8_SB(0, 0), cB, voffB); PG8_STAGE(PG8_SA(0, 0), cA, voffA); PG8_STAGE(PG8_SB(0, 1), cB + hstep, voffB); PG8_STAGE(PG8_SA(0, 1), cA + hstep, voffA);
        if (wr == 1) PG8_BAR;
        PG8_WAIT_V(4); PG8_BAR;
        PG8_STAGE(PG8_SB(1, 0), cB + kstep, voffB); PG8_STAGE(PG8_SA(1, 0), cA + kstep, voffA); PG8_STAGE(PG8_SB(1, 1), cB + hstep + kstep, voffB);
        PG8_WAIT_V(6); PG8_BAR;
    }
    for (;;) {
        const bool has_next = S.next(ui + 1, nxt);
        const char* nA = has_next ? (const char*)g.A + (size_t)nxt.pm * tstep : cA; const char* nB = has_next ? (const char*)g.Bt + (size_t)nxt.pn * tstep : cB;
#pragma nounroll
        for (int t = 0; t < nt; t += 2) {
            const bool last = (t == nt - 2);
            const char* a1 = cA + (size_t)(t + 1) * kstep;
            const char* a2 = last ? nA : cA + (size_t)(t + 2) * kstep; const char* b2 = last ? nB : cB + (size_t)(t + 2) * kstep;
            const char* a3 = a2 + kstep; const char* b3 = b2 + kstep;
            if (last && has_next) S.a_ready(nxt);
            if constexpr (SP2) {
            PG8_LDB(B0, 0, 0); PG8_LDB(B1, 0, 1); PG8_SCHED; PG8_LDA(At, 0, 0); PG8_STAGE(PG8_SA(1, 1), a1 + hstep, voffA);
            PG8_WAIT_V(8); PG8_WAIT_L(0); PG8_BAR; PG8_MMA(0, 0, At, B0); PG8_MMA(0, 1, At, B1); PG8_BAR; PG8_SCHED;
            PG8_LDA(At, 0, 1); PG8_STAGE(PG8_SB(0, 0), b2, voffB); PG8_STAGE(PG8_SB(0, 1), b2 + hstep, voffB); PG8_STAGE(PG8_SA(0, 0), a2, voffA);
            PG8_WAIT_V(8); PG8_WAIT_L(0); PG8_BAR; PG8_MMA(1, 0, At, B0); PG8_MMA(1, 1, At, B1); PG8_BAR; PG8_SCHED;
            PG8_LDB(B0, 1, 0); PG8_LDB(B1, 1, 1); PG8_SCHED; PG8_LDA(At, 1, 0); PG8_STAGE(PG8_SA(0, 1), a2 + hstep, voffA);
            PG8_WAIT_V(8); PG8_WAIT_L(0); PG8_BAR; PG8_MMA(0, 0, At, B0); PG8_MMA(0, 1, At, B1); PG8_BAR; PG8_SCHED;
            PG8_LDA(At, 1, 1); PG8_STAGE(PG8_SB(1, 0), b3, voffB); PG8_STAGE(PG8_SB(1, 1), b3 + hstep, voffB); PG8_STAGE(PG8_SA(1, 0), a3, voffA);
            PG8_WAIT_V(8); PG8_WAIT_L(0); PG8_BAR; PG8_MMA(1, 0, At, B0); PG8_MMA(1, 1, At, B1); PG8_BAR; PG8_SCHED;
            } else {
            PG8_LDB(B0, 0, 0); PG8_SCHED; PG8_LDA(At, 0, 0); PG8_STAGE(PG8_SA(1, 1), a1 + hstep, voffA);
            PG8_WAIT_L(8); PG8_BAR; PG8_WAIT_L(0); PG8_MMA(0, 0, At, B0); PG8_BAR; PG8_SCHED;
            PG8_LDB(B1, 0, 1); PG8_STAGE(PG8_SB(0, 0), b2, voffB);
            PG8_BAR; PG8_WAIT_L(0); PG8_MMA(0, 1, At, B1); PG8_BAR;
            PG8_LDA(At, 0, 1); PG8_STAGE(PG8_SA(0, 0), a2, voffA);
            PG8_BAR; PG8_WAIT_L(0); PG8_MMA(1, 0, At, B0); PG8_BAR; PG8_SCHED;
            PG8_STAGE(PG8_SB(0, 1), b2 + hstep, voffB);
            PG8_WAIT_V(6); PG8_BAR; PG8_MMA(1, 1, At, B1); PG8_BAR;
            PG8_LDB(B0, 1, 0); PG8_SCHED; PG8_LDA(At, 1, 0); PG8_STAGE(PG8_SA(0, 1), a2 + hstep, voffA);
            PG8_WAIT_L(8); PG8_BAR; PG8_WAIT_L(0); PG8_MMA(0, 0, At, B0); PG8_BAR; PG8_SCHED;
            PG8_LDB(B1, 1, 1); PG8_STAGE(PG8_SB(1, 0), b3, voffB);
            PG8_BAR; PG8_WAIT_L(0); PG8_MMA(0, 1, At, B1); PG8_BAR;
            PG8_LDA(At, 1, 1); PG8_STAGE(PG8_SA(1, 0), a3, voffA);
            PG8_BAR; PG8_WAIT_L(0); PG8_MMA(1, 0, At, B0); PG8_BAR; PG8_SCHED;
            PG8_STAGE(PG8_SB(1, 1), b3 + hstep, voffB);
            PG8_WAIT_V(6); PG8_BAR; PG8_MMA(1, 1, At, B1); PG8_BAR;
            }
        }
        if constexpr (ALIGN_EPI) { if (wr == 0) PG8_BAR; }
        if constexpr (!Epi::AFTER_DRAIN) { E(acc, cur, wr, wc, fr, fq); S.done(cur); }
        if (!has_next) break;
#pragma unroll
        for (int a = 0; a < 2; ++a)
#pragma unroll
            for (int b = 0; b < 2; ++b)
#pragma unroll
                for (int m = 0; m < 4; ++m)
#pragma unroll
                    for (int n = 0; n < 2; ++n) acc[a][b][m][n] = (f32x4){0.f, 0.f, 0.f, 0.f};
        cur = nxt; cA = nA; cB = nB; ++ui;
        if constexpr (ALIGN_EPI) { if (wr == 1) PG8_BAR; }
    }
    PG8_WAIT_V(0);
    if constexpr (!ALIGN_EPI) { if (wr == 0) PG8_BAR; }
    PG8_BAR;
    if constexpr (Epi::AFTER_DRAIN) { E.fused(acc, cur, wr, wc, fr, fq, lds, wid, lane); S.done(cur); }
#undef PG8_SA
#undef PG8_SB
#undef PG8_STAGE
#undef PG8_LDA
#undef PG8_LDB
#undef PG8_MMA
#undef PG8_CAT8
#undef PG8_WAIT_V
#undef PG8_WAIT_L
#undef PG8_BAR
#undef PG8_SCHED
}
}

#define PG8_SP2 true
#define PG8_ALIGN true

constexpr int NWAVES = 8;
constexpr int M = 16384, D = 2048, SEQ = 4096, NB = 4;
constexpr int NIN = 7680;
constexpr int IN_COLS = 7184;
constexpr int FFN = 5632, EFF = 7168, NEXP = 8, PLE = 256;
constexpr int CAP = 2 * M + NEXP * 256;
constexpr float EPS = 1e-6f;
#ifndef MK_N_LAUNCHES
#define MK_N_LAUNCHES 1
#endif
constexpr int N_PHASES = 26;
constexpr int N_LAUNCHES = MK_N_LAUNCHES;

constexpr size_t MiB = 1u << 20;
constexpr size_t WS_CTL = 0, CTL_ZERO_BYTES = 1 * MiB;
constexpr size_t WS_SMALL = 1 * MiB;
constexpr size_t SM_LB = 0, SM_L1M = 8192, SM_HIST = 16384, SM_PSTART = 24576, SM_TOPW = 65536, SM_RANKE = 196608, SM_TOKSLOT = 327680, SM_SLOTW = 458752;
constexpr size_t WS_WIN = 2 * MiB, WS_WOUT = 62 * MiB, WS_WPG = 78 * MiB, WS_WPP = 94 * MiB, WS_WGU = 96 * MiB, WS_WD = 140 * MiB, WS_MGU = 162 * MiB, WS_MD = 610 * MiB;
constexpr size_t WS_HN = 834 * MiB, WS_PB = 898 * MiB, WS_PP = 914 * MiB, WS_A = 978 * MiB, WS_XS = 1490 * MiB, WS_MIXV = 1626 * MiB, WS_PART = 1699 * MiB, WS_END = 1705 * MiB;
constexpr size_t A_QH = 0, A_KH = 32 * MiB, A_VH = 64 * MiB, A_GH = 96 * MiB, A_GATE = 160 * MiB, A_QG = 224 * MiB, A_KG = 240 * MiB, A_VG = 256 * MiB, A_GG = 288 * MiB, A_ORAW = 320 * MiB, A_O = 448 * MiB;
static_assert((size_t)CAP * EFF * 2 <= 512 * MiB && (size_t)CAP * D * 2 <= 136 * MiB && SM_SLOTW + (size_t)CAP * 4 <= MiB, "ws map");
constexpr int CW_TMO = 0, CW_CODE = 1, CW_BAR = 4096;

constexpr int RING_OFF = 0, RING_BYTES = 131072;
constexpr int LDS_BYTES = 163840;
constexpr int LDSCTL_OFF = LDS_BYTES - 512, MISC_OFF = LDSCTL_OFF + 320;

#define GAS __attribute__((address_space(1)))
#define LAS __attribute__((address_space(3)))
typedef unsigned short bf16;
typedef unsigned v4u __attribute__((ext_vector_type(4)));
typedef unsigned v2u __attribute__((ext_vector_type(2)));
typedef float f32x4 __attribute__((ext_vector_type(4)));
typedef short bf16x8 __attribute__((ext_vector_type(8)));
typedef GAS unsigned gu32;
#define RLX_AGENT __ATOMIC_RELAXED, __HIP_MEMORY_SCOPE_AGENT
#define LDS_WAIT() asm volatile("s_waitcnt lgkmcnt(0)" ::: "memory")
__device__ __forceinline__ unsigned f2bf(float f) { unsigned u = __builtin_bit_cast(unsigned, f); return (u + 0x7fffu + ((u >> 16) & 1u)) >> 16; }
__device__ __forceinline__ unsigned pk2(float lo, float hi) { return pg8::cvt_pk_bf16(lo, hi); }
__device__ __forceinline__ float bflo(unsigned u) { return __uint_as_float(u << 16); }
__device__ __forceinline__ float bfhi(unsigned u) { return __uint_as_float(u & 0xffff0000u); }
__device__ __forceinline__ float fex(float x) { return __builtin_amdgcn_exp2f(x * 1.44269504089f); }

struct Args { const float* in[22]; float* out; unsigned char* ws; int ph_lo, ph_hi, li, pad; };
typedef const __attribute__((address_space(4))) Args* KArgs;
__device__ __forceinline__ KArgs kargs() { KArgs p = (KArgs)__builtin_amdgcn_kernarg_segment_ptr(); asm volatile("" : "+s"(p)); return p; }
#define XB_TMO      128
#define XB_XCNT(j)  (256  + 64 * (j))
#define XB_XSUB(j)  (1280 + 64 * (j))
#define XB_XGEN(j)  (2304 + 64 * (j))
#define XB_TOP      3328
#define XB_TOPGEN   3392
#define XCD_BAR_WORDS 3456
#define XB_SPIN_CAP (1u << 18)

__device__ __forceinline__ unsigned xb_ld(unsigned* p)              { return __hip_atomic_load(p, __ATOMIC_RELAXED, __HIP_MEMORY_SCOPE_AGENT); }
__device__ __forceinline__ unsigned xb_add(unsigned* p, unsigned v) { return __hip_atomic_fetch_add(p, v, __ATOMIC_RELAXED, __HIP_MEMORY_SCOPE_AGENT); }
__device__ __forceinline__ unsigned xb_xcc_id() { return (unsigned)__builtin_amdgcn_s_getreg((3 << 11) | 20) & 0xFu; }
#define XB_SPIN(cond, bar) do { unsigned _sp = 0; while (cond) { __builtin_amdgcn_s_sleep(1); \
    if ((++_sp & 255u) == 0u) { if (xb_ld(&(bar)[XB_TMO])) break; if (_sp > XB_SPIN_CAP) { atomicAdd(&(bar)[XB_TMO], 1u); break; } } } } while (0)

struct XcdBarrier {
    unsigned* bar; unsigned x;
    volatile LAS unsigned* st;
};

__device__ __forceinline__ XcdBarrier xcd_barrier_post(unsigned* bar, volatile LAS unsigned* st) {
    XcdBarrier b; b.bar = bar; b.x = xb_xcc_id(); b.st = st;
    if (threadIdx.x == 0) (void)xb_add(&bar[XB_XCNT(b.x)], 1u);
    return b;
}
__device__ __forceinline__ void xcd_barrier_complete(unsigned* bar, unsigned x, unsigned& nloc, unsigned& nx) {
    const unsigned G = gridDim.x * gridDim.y * gridDim.z;
    unsigned sum, cnt, mine, sp = 0u;
    for (;;) {
        sum = 0u; cnt = 0u; mine = 0u;
#pragma unroll
        for (unsigned j = 0; j < 16; ++j) { const unsigned c = xb_ld(&bar[XB_XCNT(j)]); sum += c; cnt += (c > 0u) ? 1u : 0u; mine = (j == x) ? c : mine; }
        if (sum == G) break;
        __builtin_amdgcn_s_sleep(1);
        if ((++sp & 255u) == 0u) { if (xb_ld(&bar[XB_TMO])) break; if (sp > XB_SPIN_CAP) { atomicAdd(&bar[XB_TMO], 1u); break; } }
    }
    nloc = mine > 0u ? mine : 1u; nx = cnt > 0u ? cnt : 1u;
}

__device__ __forceinline__ void xcd_barrier(const XcdBarrier& b) {
    asm volatile("s_waitcnt vmcnt(0)" ::: "memory");
    __syncthreads();
    if (threadIdx.x == 0) {
        unsigned* bar = b.bar;
        __builtin_amdgcn_s_waitcnt(0);
        unsigned nloc = b.st[0], nx = b.st[1];
        if (nloc == 0u) { xcd_barrier_complete(bar, b.x, nloc, nx); b.st[0] = nloc; b.st[1] = nx; }
        const unsigned old = xb_add(&bar[XB_XSUB(b.x)], 1u);
        const unsigned gen = old / nloc;
        if (old + 1u == (gen + 1u) * nloc) {
            __builtin_amdgcn_fence(__ATOMIC_RELEASE, "agent");
            asm volatile("s_waitcnt vmcnt(0)" ::: "memory");
            const unsigned og = xb_add(&bar[XB_TOP], 1u);
            const unsigned tg = og / nx;
            if (og + 1u == (tg + 1u) * nx) xb_add(&bar[XB_TOPGEN], 1u);
            else XB_SPIN(xb_ld(&bar[XB_TOPGEN]) == tg, bar);
            __builtin_amdgcn_fence(__ATOMIC_ACQUIRE, "agent");
            xb_add(&bar[XB_XGEN(b.x)], 1u);
            asm volatile("s_waitcnt vmcnt(0)" ::: "memory");
        } else {
            XB_SPIN(xb_ld(&bar[XB_XGEN(b.x)]) == gen, bar);
            __builtin_amdgcn_fence(__ATOMIC_ACQUIRE, "agent");
            asm volatile("s_waitcnt vmcnt(0)" ::: "memory");
        }
    }
    __syncthreads();
}


struct Frame {
    LAS unsigned char* lds;
    volatile LAS unsigned* MISC;
    gu32* ctl;
    int tid, lane, wave, vcu, G;
    unsigned char* ws;
};
__device__ __forceinline__ float wave_sum(float v) {
#pragma unroll
    for (int o = 1; o < 64; o <<= 1) v += __shfl_xor(v, o);
    return v;
}
__device__ __forceinline__ void p0_transpose_item(const float* W, int ldw, int col0, int K, int ncols, bf16* WT, int mode, int rowoff, LAS float* scr, int item, int lane, const float* kgain = nullptr) {
    const int nblk = ncols / 32, kb = item / nblk, nb = item % nblk, k0 = 64 * kb, n0 = 32 * nb;
    const float* src = W + (size_t)k0 * ldw + col0 + n0 + (lane & 31) + (size_t)(lane >> 5) * ldw;
#pragma unroll 16
    for (int i = 0; i < 32; ++i) { const int kk = 2 * i + (lane >> 5); scr[kk * 33 + (lane & 31)] = src[(size_t)(2 * i) * ldw]; }
    LDS_WAIT(); asm volatile("" ::: "memory");
    const int c = lane & 7;
    const int rbase = mode == 0 ? rowoff + n0 : rowoff + (n0 >> 7) * 256 + (n0 & 127) + (mode == 2 ? 128 : 0);
    f32x4 ga = {1.f, 1.f, 1.f, 1.f}, gb = {1.f, 1.f, 1.f, 1.f};
    if (kgain) { ga = *(const GAS f32x4*)(kgain + k0 + 8 * c); gb = *(const GAS f32x4*)(kgain + k0 + 8 * c + 4); }
#pragma unroll
    for (int j = 0; j < 4; ++j) { const int n = (lane >> 3) + 8 * j; const LAS float* s = scr + (8 * c) * 33 + n;
        v4u o; o.x = pk2(s[0 * 33] * ga.x, s[1 * 33] * ga.y); o.y = pk2(s[2 * 33] * ga.z, s[3 * 33] * ga.w); o.z = pk2(s[4 * 33] * gb.x, s[5 * 33] * gb.y); o.w = pk2(s[6 * 33] * gb.z, s[7 * 33] * gb.w);
        *(GAS v4u*)(WT + (size_t)(rbase + n) * K + k0 + 8 * c) = o; }
    LDS_WAIT(); asm volatile("" ::: "memory");
}
__device__ __forceinline__ void p0_transpose_item8(const float* W, int ldw, int K, int ncols, unsigned char* WT, int mode, float sc, LAS float* scr, int item, int lane) {
    const int nblk = ncols / 32, kb = item / nblk, nb = item % nblk, k0 = 64 * kb, n0 = 32 * nb;
    const float* src = W + (size_t)k0 * ldw + n0 + (lane & 31) + (size_t)(lane >> 5) * ldw;
#pragma unroll 16
    for (int i = 0; i < 32; ++i) { const int kk = 2 * i + (lane >> 5); scr[kk * 33 + (lane & 31)] = src[(size_t)(2 * i) * ldw]; }
    LDS_WAIT(); asm volatile("" ::: "memory");
    const int c = lane & 3;
    const int rbase = mode == 0 ? n0 : (n0 >> 7) * 256 + (n0 & 127) + (mode == 2 ? 128 : 0);
#pragma unroll
    for (int j = 0; j < 2; ++j) { const int n = (lane >> 2) + 16 * j; const LAS float* s = scr + (16 * c) * 33 + n;
        v4u o; o.x = pg8::pk4_fp8(s[0 * 33] * sc, s[1 * 33] * sc, s[2 * 33] * sc, s[3 * 33] * sc); o.y = pg8::pk4_fp8(s[4 * 33] * sc, s[5 * 33] * sc, s[6 * 33] * sc, s[7 * 33] * sc);
        o.z = pg8::pk4_fp8(s[8 * 33] * sc, s[9 * 33] * sc, s[10 * 33] * sc, s[11 * 33] * sc); o.w = pg8::pk4_fp8(s[12 * 33] * sc, s[13 * 33] * sc, s[14 * 33] * sc, s[15 * 33] * sc);
        *(GAS v4u*)(WT + (size_t)(rbase + n) * K + k0 + 16 * c) = o; }
    LDS_WAIT(); asm volatile("" ::: "memory");
}
__device__ __forceinline__ void p0_prologue(Frame& F, KArgs ka) {
    LAS float* scr = (LAS float*)(F.lds + RING_OFF + F.wave * 16384);
    const int gw = F.vcu * NWAVES + F.wave, NGW = F.G * NWAVES;
    unsigned char* ws = F.ws;
    if (F.vcu == 0) { float* LB = (float*)(ws + WS_SMALL + SM_LB); float* L1M = (float*)(ws + WS_SMALL + SM_L1M); const float* lg_ = ka->in[4];
        for (int c = F.tid; c < 1024; c += NWAVES * 64) { const float l0 = lg_[c], l1 = lg_[1024 + c]; const float s1 = 1.0f / (1.0f + __expf(l0 - l1));
            LB[c] = 0.f; L1M[c] = 0.f; LB[1024 + c] = s1; L1M[1024 + c] = __logf(1.0f - s1); } }
    { const GAS f32x4* src = (const GAS f32x4*)ka->in[1]; GAS v2u* dst = (GAS v2u*)(ws + WS_PB); const size_t n4 = (size_t)2 * M * PLE / 4;
        for (size_t i = (size_t)gw * 64 + F.lane; i < n4; i += (size_t)NGW * 64) { const f32x4 v = src[i]; v2u o; o.x = pk2(v.x, v.y); o.y = pk2(v.z, v.w); dst[i] = o; } }
    { constexpr int NIT = 2 * 512 * 4;
        for (int it = gw; it < NIT; it += NGW) { const int l = it / 2048, r2 = it % 2048, n = r2 / 4, kg = r2 % 4; const int k0 = kg * 512 + F.lane * 8;
            const float* w2 = ka->in[6] + (size_t)l * 16 * 512 + n; float wv[16];
#pragma unroll
            for (int r = 0; r < 16; ++r) wv[r] = w2[r * 512];
            const float* wi = ka->in[3] + (size_t)l * D * IN_COLS + (size_t)k0 * IN_COLS + 6144; float o[8];
#pragma unroll
            for (int kk = 0; kk < 8; ++kk) { const f32x4 a = *(const f32x4*)(wi + (size_t)kk * IN_COLS), b = *(const f32x4*)(wi + (size_t)kk * IN_COLS + 4), c = *(const f32x4*)(wi + (size_t)kk * IN_COLS + 8), d = *(const f32x4*)(wi + (size_t)kk * IN_COLS + 12);
                o[kk] = a.x * wv[0] + a.y * wv[1] + a.z * wv[2] + a.w * wv[3] + b.x * wv[4] + b.y * wv[5] + b.z * wv[6] + b.w * wv[7] + c.x * wv[8] + c.y * wv[9] + c.z * wv[10] + c.w * wv[11] + d.x * wv[12] + d.y * wv[13] + d.z * wv[14] + d.w * wv[15]; }
            if (l == 1) { const float* gn = ka->in[2] + D + k0;
#pragma unroll
                for (int kk = 0; kk < 8; ++kk) o[kk] *= gn[kk]; }
            v4u q; q.x = pk2(o[0], o[1]); q.y = pk2(o[2], o[3]); q.z = pk2(o[4], o[5]); q.w = pk2(o[6], o[7]);
            *(GAS v4u*)((bf16*)(ws + WS_WIN) + (size_t)l * NIN * D + (size_t)(6144 + n) * D + k0) = q; } }
    constexpr int I_A = 32 * 192, I_B = 32 * 32, I_C = 32 * 64, I_E = 4 * 64, I_F = 32 * 176, I_G = 88 * 64, I_H = 32 * 224, I_I = 112 * 64;
    constexpr int NITEMS = 2 * (I_A + I_B + 2 * I_C + I_E) + 2 * I_F + I_G + 8 * (2 * I_H + I_I);
    for (int it = gw; it < NITEMS; it += NGW) {
        int r = it;
        if (r < 2 * I_A) { const int l = r / I_A; p0_transpose_item(ka->in[3] + (size_t)l * D * IN_COLS, IN_COLS, 0, D, 6144, (bf16*)(ws + WS_WIN) + (size_t)l * NIN * D, 0, 0, scr, r % I_A, F.lane, l == 1 ? ka->in[2] + D : nullptr); continue; } r -= 2 * I_A;
        if (r < 2 * I_B) { const int l = r / I_B; p0_transpose_item(ka->in[3] + (size_t)l * D * IN_COLS, IN_COLS, 6160, D, 1024, (bf16*)(ws + WS_WIN) + (size_t)l * NIN * D, 0, 6656, scr, r % I_B, F.lane, l == 1 ? ka->in[2] + D : nullptr); continue; } r -= 2 * I_B;
        if (r < 2 * I_C) { const int l = r / I_C; p0_transpose_item(ka->in[9] + (size_t)l * D * D, D, 0, D, D, (bf16*)(ws + WS_WOUT) + (size_t)l * D * D, 0, 0, scr, r % I_C, F.lane); continue; } r -= 2 * I_C;
        if (r < I_C) { p0_transpose_item(ka->in[19], D, 0, D, D, (bf16*)(ws + WS_WPG), 0, 0, scr, r, F.lane, ka->in[18]); continue; } r -= I_C;
        if (r < I_C) { p0_transpose_item8(ka->in[19] + (size_t)D * D, D, D, D, ws + WS_WPG + 8 * MiB, 0, pg8::F8_SWU, scr, r, F.lane); continue; } r -= I_C;
        if (r < 2 * I_E) { const int l = r / I_E; p0_transpose_item(ka->in[20] + (size_t)l * PLE * D, D, 0, PLE, D, (bf16*)(ws + WS_WPP) + (size_t)l * D * PLE, 0, 0, scr, r % I_E, F.lane); continue; } r -= 2 * I_E;
        if (r < I_F) { p0_transpose_item(ka->in[11], FFN, 0, D, FFN, (bf16*)(ws + WS_WGU), 1, 0, scr, r, F.lane, ka->in[10]); continue; } r -= I_F;
        if (r < I_F) { p0_transpose_item(ka->in[12], FFN, 0, D, FFN, (bf16*)(ws + WS_WGU), 2, 0, scr, r, F.lane, ka->in[10]); continue; } r -= I_F;
        if (r < I_G) { p0_transpose_item(ka->in[13], D, 0, FFN, D, (bf16*)(ws + WS_WD), 0, 0, scr, r, F.lane); continue; } r -= I_G;
        if (r < 8 * I_H) { const int e = r / I_H; p0_transpose_item8(ka->in[15] + (size_t)e * D * EFF, EFF, D, EFF, ws + WS_MGU + (size_t)e * 2 * EFF * D, 1, pg8::F8_SWU, scr, r % I_H, F.lane); continue; } r -= 8 * I_H;
        if (r < 8 * I_H) { const int e = r / I_H; p0_transpose_item8(ka->in[16] + (size_t)e * D * EFF, EFF, D, EFF, ws + WS_MGU + (size_t)e * 2 * EFF * D, 2, pg8::F8_SWU, scr, r % I_H, F.lane); continue; } r -= 8 * I_H;
        { const int e = r / I_I; p0_transpose_item8(ka->in[17] + (size_t)e * EFF * D, D, EFF, D, ws + WS_MD + (size_t)e * D * EFF, 0, pg8::F8_SWD, scr, r % I_I, F.lane); }
    }
}

constexpr int RSTD_OFF = RING_BYTES;
__device__ __forceinline__ int prep_rstd(Frame& F, const float* part) {
    const int rbase = ((int)blockIdx.x & 7) * 2048;
    LAS float* rt = (LAS float*)(F.lds + RSTD_OFF);
    for (int r = F.tid; r < 2048; r += NWAVES * 64) { const GAS f32x4* p = (const GAS f32x4*)(part + (size_t)(rbase + r) * 32);
        float s = 0.f;
#pragma unroll
        for (int j = 0; j < 8; ++j) { const f32x4 a = p[j]; s += (a.x + a.y) + (a.z + a.w); }
        rt[r] = 1.0f / sqrtf(s * (1.0f / D) + EPS); }
    __syncthreads();
    return rbase;
}
__device__ __forceinline__ void load_row(const float* row, int lane, f32x4 (&v)[8]) {
    const GAS f32x4* xr = (const GAS f32x4*)row + lane;
#pragma unroll
    for (int j = 0; j < 8; ++j) v[j] = xr[64 * j];
}
__device__ __forceinline__ float row_rstd(const f32x4 (&v)[8]) {
    float s = 0.f;
#pragma unroll
    for (int j = 0; j < 8; ++j) s += (v[j].x * v[j].x + v[j].y * v[j].y) + (v[j].z * v[j].z + v[j].w * v[j].w);
    return 1.0f / sqrtf(wave_sum(s) * (1.0f / D) + EPS);
}
__device__ __forceinline__ void norm_store_bf16(f32x4 (&v)[8], float rstd, const float* w, bf16* orow, int lane) {
    const GAS f32x4* wr = (const GAS f32x4*)w + lane; GAS v2u* o8 = (GAS v2u*)orow + lane;
#pragma unroll
    for (int j = 0; j < 8; ++j) { v[j] = v[j] * rstd * wr[64 * j]; v2u o; o.x = pk2(v[j].x, v[j].y); o.y = pk2(v[j].z, v[j].w); o8[64 * j] = o; }
}
__device__ __forceinline__ void norm_store_fp8(f32x4 (&v)[8], float rstd, const float* w, unsigned char* orow, int lane) {
    const GAS f32x4* wr = (const GAS f32x4*)w + lane; GAS unsigned* o4 = (GAS unsigned*)orow + lane;
#pragma unroll
    for (int j = 0; j < 8; ++j) { v[j] = v[j] * rstd * wr[64 * j]; o4[64 * j] = pg8::pk4_fp8(v[j].x * pg8::F8_SA, v[j].y * pg8::F8_SA, v[j].z * pg8::F8_SA, v[j].w * pg8::F8_SA); }
}
template <bool F8OUT> __device__ __forceinline__ void norm_phase(Frame& F, const float* Hsrc, const float* w, bf16* HN) {
    const int gw = F.vcu * NWAVES + F.wave, NGW = F.G * NWAVES;
    for (int m = gw; m < M; m += NGW) { f32x4 v[8]; load_row(Hsrc + (size_t)m * D, F.lane, v); const float rstd = row_rstd(v);
        if (F8OUT) norm_store_fp8(v, rstd, w, (unsigned char*)HN + (size_t)m * D, F.lane); else norm_store_bf16(v, rstd, w, HN + (size_t)m * D, F.lane); }
}
__device__ __forceinline__ void final_norm_phase(Frame& F, float* Hio, const float* w) {
    const int gw = F.vcu * NWAVES + F.wave, NGW = F.G * NWAVES;
    for (int m = gw; m < M; m += NGW) { f32x4 v[8]; load_row(Hio + (size_t)m * D, F.lane, v); const float rstd = row_rstd(v);
        const GAS f32x4* wr = (const GAS f32x4*)w + F.lane; GAS f32x4* o = (GAS f32x4*)(Hio + (size_t)m * D) + F.lane;
#pragma unroll
        for (int j = 0; j < 8; ++j) o[64 * j] = v[j] * rstd * wr[64 * j]; }
}
__device__ __forceinline__ void postmix_phase(Frame& F, const float* ORAW, const bf16* GATE, const float* hw, const float* gw_, bf16* O) {
    const int gw = F.vcu * NWAVES + F.wave, NGW = F.G * NWAVES;
    for (int m = gw; m < M; m += NGW) { f32x4 v[8]; load_row(ORAW + (size_t)m * D, F.lane, v);
        const GAS v2u* gr = (const GAS v2u*)(GATE + (size_t)m * D) + F.lane; GAS v2u* o8 = (GAS v2u*)(O + (size_t)m * D) + F.lane;
#pragma unroll
        for (int j = 0; j < 8; ++j) { float s = (v[j].x * v[j].x + v[j].y * v[j].y) + (v[j].z * v[j].z + v[j].w * v[j].w);
#pragma unroll
            for (int o = 1; o < 32; o <<= 1) s += __shfl_xor(s, o);
            float rstd;
            if (j < 4) rstd = 1.0f / sqrtf(s * (1.0f / 128.0f) + EPS); else { s += __shfl_xor(s, 32); rstd = 1.0f / sqrtf(s * (1.0f / 256.0f) + EPS); }
            const f32x4 wv = j < 4 ? ((const GAS f32x4*)hw + F.lane)[64 * j] : ((const GAS f32x4*)gw_ + F.lane)[64 * (j - 4)];
            const v2u g = gr[64 * j]; const f32x4 y = v[j] * rstd * wv;
            v2u o; o.x = pk2(y.x * bflo(g.x), y.y * bfhi(g.x)); o.y = pk2(y.z * bflo(g.y), y.w * bfhi(g.y)); o8[64 * j] = o; } }
}
__device__ __forceinline__ void norm_router_phase(Frame& F, const float* Hsrc, const float* w, const float* RW, unsigned char* HN8) {
    LAS float* RWt = (LAS float*)(F.lds + RING_OFF);
    LAS int* ESEL = (LAS int*)(F.lds + RING_OFF + 65536);
    for (int i = F.tid; i < 8 * D; i += NWAVES * 64) { const int k = i >> 3, e = i & 7; RWt[e * D + k] = RW[i]; }
    __syncthreads();
    float2* TOPW = (float2*)(F.ws + WS_SMALL + SM_TOPW); int* RANKE = (int*)(F.ws + WS_SMALL + SM_RANKE); int* HIST = (int*)(F.ws + WS_SMALL + SM_HIST);
    for (int chunk = F.vcu; chunk < M / 64; chunk += F.G) {
        for (int i = 0; i < 8; ++i) { const int rl = F.wave * 8 + i, m = chunk * 64 + rl;
            f32x4 v[8]; load_row(Hsrc + (size_t)m * D, F.lane, v); const float rstd = row_rstd(v); norm_store_fp8(v, rstd, w, HN8 + (size_t)m * D, F.lane);
            float lgt[8];
#pragma unroll
            for (int e = 0; e < 8; ++e) { float p = 0.f;
#pragma unroll
                for (int j = 0; j < 8; ++j) { const f32x4 t = *(const LAS f32x4*)(RWt + e * D + 256 * j + 4 * F.lane); p += (v[j].x * t.x + v[j].y * t.y) + (v[j].z * t.z + v[j].w * t.w); }
                lgt[e] = wave_sum(p); }
            int e0 = 0; float l0 = lgt[0];
#pragma unroll
            for (int e = 1; e < 8; ++e) if (lgt[e] > l0) { l0 = lgt[e]; e0 = e; }
            int e1 = -1; float l1 = -3.0e38f;
#pragma unroll
            for (int e = 0; e < 8; ++e) if (e != e0 && lgt[e] > l1) { l1 = lgt[e]; e1 = e; }
            const float w0 = 1.0f / (1.0f + __expf(l1 - l0));
            if (F.lane == 0) { ESEL[rl] = e0 | (e1 << 8); TOPW[m] = make_float2(w0, 1.0f - w0); } }
        __syncthreads();
        if (F.tid < 128) { const int a = F.tid, tok = a >> 1, kk = a & 1; const int ev = ESEL[tok]; const int e = kk ? (ev >> 8) : (ev & 255); int rank = 0;
            for (int a2 = 0; a2 < a; ++a2) { const int ev2 = ESEL[a2 >> 1]; const int e2 = (a2 & 1) ? (ev2 >> 8) : (ev2 & 255); rank += (e2 == e) ? 1 : 0; }
            RANKE[(chunk * 64 + tok) * 2 + kk] = e | (rank << 8); }
        if (F.tid >= 128 && F.tid < 136) { const int e = F.tid - 128; int cnt = 0;
            for (int t = 0; t < 64; ++t) { const int ev = ESEL[t]; cnt += ((ev & 255) == e) + ((ev >> 8) == e); }
            HIST[chunk * 8 + e] = cnt; }
        __syncthreads();
    }
}
__device__ __forceinline__ void moe_scatter_phase(Frame& F, const unsigned char* HN8, unsigned char* XS) {
    LAS int* HS = (LAS int*)(F.lds + RING_OFF);
    LAS int* PT = (LAS int*)(F.lds + RING_OFF + 8192);
    LAS int* BASE = (LAS int*)(F.lds + RING_OFF + 8192 + 512);
    const int* HIST = (const int*)(F.ws + WS_SMALL + SM_HIST); const int* RANKE = (const int*)(F.ws + WS_SMALL + SM_RANKE); const float* TOPW = (const float*)(F.ws + WS_SMALL + SM_TOPW);
    int* TOKSLOT = (int*)(F.ws + WS_SMALL + SM_TOKSLOT); float* SLOTW = (float*)(F.ws + WS_SMALL + SM_SLOTW); int* PSTART = (int*)(F.ws + WS_SMALL + SM_PSTART);
    bool first = true;
    for (int chunk = F.vcu; chunk < M / 64; chunk += F.G) {
        if (F.tid < 256) { const GAS v4u* h = (const GAS v4u*)(HIST + F.tid * 8); *(LAS v4u*)(HS + F.tid * 8) = h[0]; *(LAS v4u*)(HS + F.tid * 8 + 4) = h[1]; }
        __syncthreads();
        if (F.tid < 64) { const int e = F.tid & 7, part = F.tid >> 3; int tot = 0, pre = 0;
            for (int cc = part * 32; cc < part * 32 + 32; ++cc) { const int h = HS[cc * 8 + e]; tot += h; pre += (cc < chunk) ? h : 0; }
            PT[F.tid] = tot; PT[64 + F.tid] = pre; }
        __syncthreads();
        if (F.tid == 0) { int ps = 0;
            for (int e = 0; e < 8; ++e) { int tot = 0, pre = 0; for (int p = 0; p < 8; ++p) { tot += PT[p * 8 + e]; pre += PT[64 + p * 8 + e]; }
                BASE[e] = ps + pre; BASE[8 + e] = ps; ps += (tot + 255) & ~255; }
            BASE[16] = ps; }
        __syncthreads();
        if (F.vcu == 0 && first && F.tid < 9) PSTART[F.tid] = BASE[8 + F.tid];
        first = false;
        for (int a = F.wave * 16; a < F.wave * 16 + 16; ++a) { const int tok = chunk * 64 + (a >> 1), kk = a & 1; const int re = RANKE[tok * 2 + kk]; const int slot = BASE[re & 255] + (re >> 8);
            const GAS v4u* src = (const GAS v4u*)(HN8 + (size_t)tok * D) + F.lane; GAS v4u* dst = (GAS v4u*)(XS + (size_t)slot * D) + F.lane;
#pragma unroll
            for (int j = 0; j < 2; ++j) dst[64 * j] = src[64 * j];
            if (F.lane == 0) { TOKSLOT[tok * 2 + kk] = slot; SLOTW[slot] = TOPW[tok * 2 + kk]; } }
        __syncthreads();
    }
}
__device__ __forceinline__ void combine_norm_phase(Frame& F, float* Hio, const bf16* YS, const float* w, bf16* HN) {
    const int gw = F.vcu * NWAVES + F.wave, NGW = F.G * NWAVES; const int* TOKSLOT = (const int*)(F.ws + WS_SMALL + SM_TOKSLOT);
    for (int m = gw; m < M; m += NGW) { f32x4 v[8]; load_row(Hio + (size_t)m * D, F.lane, v);
        const int s0 = TOKSLOT[2 * m], s1 = TOKSLOT[2 * m + 1];
        const GAS v2u* y0 = (const GAS v2u*)(YS + (size_t)s0 * D) + F.lane; const GAS v2u* y1 = (const GAS v2u*)(YS + (size_t)s1 * D) + F.lane; GAS f32x4* ho = (GAS f32x4*)(Hio + (size_t)m * D) + F.lane;
#pragma unroll
        for (int j = 0; j < 8; ++j) { const v2u a = y0[64 * j], b = y1[64 * j];
            v[j].x += bflo(a.x) + bflo(b.x); v[j].y += bfhi(a.x) + bfhi(b.x); v[j].z += bflo(a.y) + bflo(b.y); v[j].w += bfhi(a.y) + bfhi(b.y); ho[64 * j] = v[j]; }
        const float rstd = row_rstd(v); norm_store_fp8(v, rstd, w, (unsigned char*)HN + (size_t)m * D, F.lane); }
}
constexpr int MX_QP = 272, MX_TP = 144;
constexpr int IM_QT = 0, IM_KTT = 17408, IM_PM = 35840, IM_RV = 45056, IM_LV = 45568, IM_BYTES = 46080;
constexpr int NITEM_H = NB * 8 * (SEQ / 64), NITEM_G = NB * 4 * (SEQ / 64);
constexpr int VT_H = 128 * MX_TP, VT_G = 256 * MX_TP;
constexpr int PX_SEG = 0, PX_RV = 8192, PX_LV = 8704, PX_QT = 9216, PX_KT = 26624, PX_KTT = 44032, PX_PM = 62464, PX_VT = 71680, PX_END = 108544;
#define MX_BAR() do { asm volatile("s_waitcnt lgkmcnt(0)" ::: "memory"); __builtin_amdgcn_s_barrier(); asm volatile("" ::: "memory"); } while (0)

__device__ __forceinline__ void mixpre_phase(Frame& F) {
    LAS unsigned char* L = F.lds + RING_OFF;
    unsigned char* A = F.ws + WS_A;
    const int tid = F.tid, lane = F.lane, w = F.wave;
    const int cq = tid & 31, rs = tid >> 5;
    const int tv = tid >> 3, vq = tid & 7;
    const int n = lane & 15, q4 = lane >> 4;
    f32x4 g[4]; v2u qv[4], kv[4]; v4u vv[4];
#define PX_LOAD(IT) do { const int it_ = (IT); const bool hg_ = it_ < NITEM_H; const int i2_ = hg_ ? it_ : it_ - NITEM_H; \
        const int b_ = hg_ ? (i2_ >> 9) : (i2_ >> 8), h_ = hg_ ? ((i2_ >> 6) & 7) : ((i2_ >> 6) & 3), c_ = i2_ & 63; \
        const size_t t0_ = (size_t)b_ * SEQ + (size_t)c_ * 64; const int wqk_ = hg_ ? 1024 : 512; \
        const bf16* Qp_ = (const bf16*)(A + (hg_ ? A_QH : A_QG)) + h_ * 128; const bf16* Kp_ = (const bf16*)(A + (hg_ ? A_KH : A_KG)) + h_ * 128; \
        const float* Gp_ = (const float*)(A + (hg_ ? A_GH : A_GG)) + h_ * 128; const bf16* Vp_ = (const bf16*)(A + (hg_ ? A_VH : A_VG)) + h_ * (hg_ ? 128 : 256); \
        _Pragma("unroll") for (int r = 0; r < 4; ++r) { const size_t ro = (t0_ + 4 * rs + r) * wqk_ + 4 * cq; \
            g[r] = *(const GAS f32x4*)(Gp_ + ro); qv[r] = *(const GAS v2u*)(Qp_ + ro); kv[r] = *(const GAS v2u*)(Kp_ + ro); } \
        const GAS v4u* vp_ = (const GAS v4u*)(Vp_ + (t0_ + tv) * 1024 + (hg_ ? 16 : 32) * vq); \
        vv[0] = vp_[0]; vv[1] = vp_[1]; if (!hg_) { vv[2] = vp_[2]; vv[3] = vp_[3]; } else { vv[2] = vv[0]; vv[3] = vv[0]; } } while (0)
    if (F.vcu < NITEM_H + NITEM_G) PX_LOAD(F.vcu);
    for (int it = F.vcu; it < NITEM_H + NITEM_G; it += F.G) {
        const bool hg = it < NITEM_H; const int i2 = hg ? it : it - NITEM_H;
        unsigned char* imq = F.ws + WS_XS + (size_t)it * IM_BYTES;
        unsigned char* imv = F.ws + WS_MIXV + (hg ? (size_t)i2 * VT_H : (size_t)NITEM_H * VT_H + (size_t)i2 * VT_G);
        f32x4 pre[4]; pre[0] = g[0]; pre[1] = pre[0] + g[1]; pre[2] = pre[1] + g[2]; pre[3] = pre[2] + g[3];
        *(LAS f32x4*)(L + PX_SEG + (rs * 128 + 4 * cq) * 4) = pre[3];
#pragma unroll
        for (int j = 0; j < 4; ++j) if (j < 2 || !hg) { const int c0 = (hg ? 16 : 32) * vq + 8 * j; const v4u x = vv[j];
            LAS unsigned short* vt = (LAS unsigned short*)(L + PX_VT + 2 * tv);
            vt[(c0 + 0) * (MX_TP / 2)] = (unsigned short)(x.x & 0xffffu); vt[(c0 + 1) * (MX_TP / 2)] = (unsigned short)(x.x >> 16); vt[(c0 + 2) * (MX_TP / 2)] = (unsigned short)(x.y & 0xffffu); vt[(c0 + 3) * (MX_TP / 2)] = (unsigned short)(x.y >> 16);
            vt[(c0 + 4) * (MX_TP / 2)] = (unsigned short)(x.z & 0xffffu); vt[(c0 + 5) * (MX_TP / 2)] = (unsigned short)(x.z >> 16); vt[(c0 + 6) * (MX_TP / 2)] = (unsigned short)(x.w & 0xffffu); vt[(c0 + 7) * (MX_TP / 2)] = (unsigned short)(x.w >> 16); }
        MX_BAR();
        f32x4 off = {0.f, 0.f, 0.f, 0.f};
#pragma unroll
        for (int s = 0; s < 15; ++s) { const f32x4 t = *(const LAS f32x4*)(L + PX_SEG + (s * 128 + 4 * cq) * 4); const float m = (s < rs) ? 1.0f : 0.0f; off += t * m; }
#pragma unroll
        for (int r = 0; r < 4; ++r) pre[r] += off;
        if (rs == 7) *(LAS f32x4*)(L + PX_RV + 16 * cq) = pre[3];
        if (rs == 15) *(LAS f32x4*)(L + PX_LV + 16 * cq) = pre[3];
        MX_BAR();
        const f32x4 Rv = *(const LAS f32x4*)(L + PX_RV + 16 * cq);
        unsigned kt[4][2];
#pragma unroll
        for (int r = 0; r < 4; ++r) { const f32x4 d = pre[r] - Rv; const int row = 4 * rs + r;
            const float q0 = bflo(qv[r].x) * fex(d.x), q1 = bfhi(qv[r].x) * fex(d.y), q2 = bflo(qv[r].y) * fex(d.z), q3 = bfhi(qv[r].y) * fex(d.w);
            const float k0 = bflo(kv[r].x) * fex(-d.x), k1 = bfhi(kv[r].x) * fex(-d.y), k2 = bflo(kv[r].y) * fex(-d.z), k3 = bfhi(kv[r].y) * fex(-d.w);
            v2u qo; qo.x = pk2(q0, q1); qo.y = pk2(q2, q3); kt[r][0] = pk2(k0, k1); kt[r][1] = pk2(k2, k3); v2u ko; ko.x = kt[r][0]; ko.y = kt[r][1];
            *(LAS v2u*)(L + PX_QT + row * MX_QP + 8 * cq) = qo; *(LAS v2u*)(L + PX_KT + row * MX_QP + 8 * cq) = ko; }
        { v2u t0_; t0_.x = (kt[0][0] & 0xffffu) | (kt[1][0] << 16); t0_.y = (kt[2][0] & 0xffffu) | (kt[3][0] << 16);
          v2u t1_; t1_.x = (kt[0][0] >> 16) | (kt[1][0] & 0xffff0000u); t1_.y = (kt[2][0] >> 16) | (kt[3][0] & 0xffff0000u);
          v2u t2_; t2_.x = (kt[0][1] & 0xffffu) | (kt[1][1] << 16); t2_.y = (kt[2][1] & 0xffffu) | (kt[3][1] << 16);
          v2u t3_; t3_.x = (kt[0][1] >> 16) | (kt[1][1] & 0xffff0000u); t3_.y = (kt[2][1] >> 16) | (kt[3][1] & 0xffff0000u);
          *(LAS v2u*)(L + PX_KTT + (4 * cq + 0) * MX_TP + 8 * rs) = t0_; *(LAS v2u*)(L + PX_KTT + (4 * cq + 1) * MX_TP + 8 * rs) = t1_;
          *(LAS v2u*)(L + PX_KTT + (4 * cq + 2) * MX_TP + 8 * rs) = t2_; *(LAS v2u*)(L + PX_KTT + (4 * cq + 3) * MX_TP + 8 * rs) = t3_; }
        MX_BAR();
        if (it + F.G < NITEM_H + NITEM_G) PX_LOAD(it + F.G);
        const int ti = w >> 1;
#pragma unroll
        for (int t2 = 0; t2 < 2; ++t2) { const int tj = 2 * (w & 1) + t2; f32x4 acc = {0.f, 0.f, 0.f, 0.f};
            if (tj <= ti) {
#pragma unroll
                for (int s = 0; s < 4; ++s) { const bf16x8 a = *(const LAS bf16x8*)(L + PX_KT + (16 * tj + n) * MX_QP + 64 * s + 16 * q4); const bf16x8 bb = *(const LAS bf16x8*)(L + PX_QT + (16 * ti + n) * MX_QP + 64 * s + 16 * q4);
                    acc = __builtin_amdgcn_mfma_f32_16x16x32_bf16(a, bb, acc, 0, 0, 0); } }
            const int i = 16 * ti + n, jj = 16 * tj + 4 * q4;
            const float p0 = (jj + 0 <= i) ? acc[0] : 0.f, p1 = (jj + 1 <= i) ? acc[1] : 0.f, p2 = (jj + 2 <= i) ? acc[2] : 0.f, p3 = (jj + 3 <= i) ? acc[3] : 0.f;
            v2u po; po.x = pk2(p0, p1); po.y = pk2(p2, p3);
            *(LAS v2u*)(L + PX_PM + i * MX_TP + 2 * jj) = po; }
        MX_BAR();
        for (int i = tid; i < 17408 / 16; i += NWAVES * 64) *(GAS v4u*)(imq + IM_QT + 16 * i) = *(const LAS v4u*)(L + PX_QT + 16 * i);
        for (int i = tid; i < 18432 / 16; i += NWAVES * 64) *(GAS v4u*)(imq + IM_KTT + 16 * i) = *(const LAS v4u*)(L + PX_KTT + 16 * i);
        for (int i = tid; i < 9216 / 16; i += NWAVES * 64) *(GAS v4u*)(imq + IM_PM + 16 * i) = *(const LAS v4u*)(L + PX_PM + 16 * i);
        if (tid < 64) *(GAS v4u*)(imq + IM_RV + 16 * tid) = *(const LAS v4u*)(L + PX_RV + 16 * tid);
        for (int i = tid; i < (hg ? VT_H : VT_G) / 16; i += NWAVES * 64) *(GAS v4u*)(imv + 16 * i) = *(const LAS v4u*)(L + PX_VT + 16 * i);
        MX_BAR();
    }
#undef PX_LOAD
}

constexpr int SQ_VT = IM_BYTES, SQ_BUF = IM_BYTES + 5120, SQ_SPT = 3 * SQ_BUF, SQ_END = SQ_SPT + 32 * MX_QP;
static_assert(SQ_END <= LDSCTL_OFF && PX_END <= LDSCTL_OFF, "mixer LDS");
__device__ __forceinline__ void mixseq_unit(Frame& F, const unsigned char* imq0, const unsigned char* imv0, int vtstride, float* Op, int tok0) {
    LAS unsigned char* L = F.lds + RING_OFF;
    const unsigned lbase = (unsigned)(size_t)L;
    const int lane = F.lane, w = F.wave, n = lane & 15, q4 = lane >> 4, ti = w >> 1, tv2 = w & 1;
    f32x4 S0 = {0.f, 0.f, 0.f, 0.f}, S1 = {0.f, 0.f, 0.f, 0.f};
#define SQ_DMA(c, buf) do { const unsigned char* iq_ = imq0 + (size_t)(c) * IM_BYTES; const unsigned char* iv_ = imv0 + (size_t)(c) * vtstride; \
        _Pragma("unroll") for (int k_ = 0; k_ < 7; ++k_) { const int p_ = w + 8 * k_; if (p_ < 50) { \
            const unsigned char* src_ = p_ < 45 ? iq_ + p_ * 1024 : iv_ + (p_ - 45) * 1024; \
            pg8::glds16_s((const char*)src_, (unsigned)lane * 16u, lbase + (unsigned)((buf) * SQ_BUF + p_ * 1024)); } } } while (0)
    SQ_DMA(0, 0); SQ_DMA(1, 1);
    int cb = 0;
    for (int c = 0; c < SEQ / 64; ++c) {
        const int bo = cb * SQ_BUF;
        if (c + 1 < SEQ / 64) asm volatile("s_waitcnt vmcnt(6)" ::: "memory"); else asm volatile("s_waitcnt vmcnt(0)" ::: "memory");
        MX_BAR();
        { const int nb = cb == 0 ? 2 : cb - 1;
          if (c + 2 < SEQ / 64) SQ_DMA(c + 2, nb); }
        const f32x4 Rd = *(const LAS f32x4*)(L + bo + IM_RV + 4 * (16 * w + 4 * q4)), Ld = *(const LAS f32x4*)(L + bo + IM_LV + 4 * (16 * w + 4 * q4));
        { const f32x4 eR = {fex(Rd.x), fex(Rd.y), fex(Rd.z), fex(Rd.w)};
          const f32x4 a = S0 * eR, b = S1 * eR; v2u o0, o1; o0.x = pk2(a.x, a.y); o0.y = pk2(a.z, a.w); o1.x = pk2(b.x, b.y); o1.y = pk2(b.z, b.w);
          *(LAS v2u*)(L + SQ_SPT + n * MX_QP + 2 * (16 * w + 4 * q4)) = o0; *(LAS v2u*)(L + SQ_SPT + (n + 16) * MX_QP + 2 * (16 * w + 4 * q4)) = o1; }
        f32x4 u0 = {0.f, 0.f, 0.f, 0.f}, u1 = {0.f, 0.f, 0.f, 0.f};
#pragma unroll
        for (int s = 0; s < 2; ++s) { const bf16x8 a = *(const LAS bf16x8*)(L + bo + IM_KTT + (16 * w + n) * MX_TP + 64 * s + 16 * q4);
            const bf16x8 b0 = *(const LAS bf16x8*)(L + bo + SQ_VT + n * MX_TP + 64 * s + 16 * q4), b1 = *(const LAS bf16x8*)(L + bo + SQ_VT + (16 + n) * MX_TP + 64 * s + 16 * q4);
            u0 = __builtin_amdgcn_mfma_f32_16x16x32_bf16(a, b0, u0, 0, 0, 0); u1 = __builtin_amdgcn_mfma_f32_16x16x32_bf16(a, b1, u1, 0, 0, 0); }
        { const f32x4 eG = {fex(Ld.x), fex(Ld.y), fex(Ld.z), fex(Ld.w)}; const f32x4 eL = {fex(Ld.x - Rd.x), fex(Ld.y - Rd.y), fex(Ld.z - Rd.z), fex(Ld.w - Rd.w)};
          S0 = S0 * eG + u0 * eL; S1 = S1 * eG + u1 * eL; }
        MX_BAR();
        { f32x4 acc = {0.f, 0.f, 0.f, 0.f};
#pragma unroll
          for (int s = 0; s < 2; ++s) { const bf16x8 a = *(const LAS bf16x8*)(L + bo + SQ_VT + (16 * tv2 + n) * MX_TP + 64 * s + 16 * q4); const bf16x8 b = *(const LAS bf16x8*)(L + bo + IM_PM + (16 * ti + n) * MX_TP + 64 * s + 16 * q4);
              acc = __builtin_amdgcn_mfma_f32_16x16x32_bf16(a, b, acc, 0, 0, 0); }
#pragma unroll
          for (int s = 0; s < 4; ++s) { const bf16x8 a = *(const LAS bf16x8*)(L + SQ_SPT + (16 * tv2 + n) * MX_QP + 64 * s + 16 * q4); const bf16x8 b = *(const LAS bf16x8*)(L + bo + IM_QT + (16 * ti + n) * MX_QP + 64 * s + 16 * q4);
              acc = __builtin_amdgcn_mfma_f32_16x16x32_bf16(a, b, acc, 0, 0, 0); }
          *(GAS f32x4*)(Op + (size_t)(tok0 + c * 64 + 16 * ti + n) * D + 16 * tv2 + 4 * q4) = acc; }
        cb = cb == 2 ? 0 : cb + 1;
    }
#undef SQ_DMA
}
__device__ __forceinline__ void mixseq_phase(Frame& F) {
    unsigned char* A = F.ws + WS_A;
    for (int u = F.vcu; u < 256; u += F.G) {
        const bool hg = u < 128; const int u2 = hg ? u : u - 128, b = u2 >> 5;
        const int h = hg ? ((u2 & 31) >> 2) : ((u2 & 31) >> 3), vs = hg ? (u2 & 3) : (u2 & 7);
        const int item0 = hg ? (b * 8 + h) * 64 : NITEM_H + (b * 4 + h) * 64;
        const unsigned char* imq0 = F.ws + WS_XS + (size_t)item0 * IM_BYTES;
        const unsigned char* imv0 = F.ws + WS_MIXV + (hg ? (size_t)(item0) * VT_H : (size_t)NITEM_H * VT_H + (size_t)(item0 - NITEM_H) * VT_G) + (size_t)vs * (32 * MX_TP);
        float* Op = (float*)(A + A_ORAW) + (hg ? h * 128 : 1024 + h * 256) + vs * 32;
        mixseq_unit(F, imq0, imv0, hg ? VT_H : VT_G, Op, b * SEQ);
        asm volatile("s_waitcnt vmcnt(0)" ::: "memory"); __syncthreads();
    }
}


#define EN_LIST(X) X(P0) X(NORM1) X(INPROJ) X(PP) X(MIX) X(POST) X(OUT) X(NORM2) X(FUP) X(FDN) X(NORM3) X(SCAT) X(MUP) X(MDN) X(COMB) X(PLE) X(FIN)
#ifndef EN_DEFAULT
#define EN_DEFAULT 1
#endif
#ifndef EN_P0
#define EN_P0 EN_DEFAULT
#endif
#ifndef EN_NORM1
#define EN_NORM1 EN_DEFAULT
#endif
#ifndef EN_INPROJ
#define EN_INPROJ EN_DEFAULT
#endif
#ifndef EN_PP
#define EN_PP EN_DEFAULT
#endif
#ifndef EN_MIX
#define EN_MIX EN_DEFAULT
#endif
#ifndef EN_POST
#define EN_POST EN_DEFAULT
#endif
#ifndef EN_OUT
#define EN_OUT EN_DEFAULT
#endif
#ifndef EN_NORM2
#define EN_NORM2 EN_DEFAULT
#endif
#ifndef EN_FUP
#define EN_FUP EN_DEFAULT
#endif
#ifndef EN_FDN
#define EN_FDN EN_DEFAULT
#endif
#ifndef EN_NORM3
#define EN_NORM3 EN_DEFAULT
#endif
#ifndef EN_SCAT
#define EN_SCAT EN_DEFAULT
#endif
#ifndef EN_MUP
#define EN_MUP EN_DEFAULT
#endif
#ifndef EN_MDN
#define EN_MDN EN_DEFAULT
#endif
#ifndef EN_COMB
#define EN_COMB EN_DEFAULT
#endif
#ifndef EN_PLE
#define EN_PLE EN_DEFAULT
#endif
#ifndef EN_FIN
#define EN_FIN EN_DEFAULT
#endif
__global__ void __launch_bounds__(NWAVES * 64, 2) hymba_fwd(Args args) {
    extern __shared__ __attribute__((aligned(16))) unsigned char lds[];
    Frame F;
    F.lds = (LAS unsigned char*)lds;
    F.MISC = (volatile LAS unsigned*)(F.lds + MISC_OFF);
    F.G = gridDim.x; { const int bx = blockIdx.x; F.vcu = (F.G % 8 == 0) ? (bx % 8) * (F.G / 8) + bx / 8 : bx; }
#define ENTER() KArgs ka = kargs(); { int t_ = threadIdx.x; asm volatile("" : "+v"(t_)); F.tid = t_; F.lane = t_ & 63; F.wave = __builtin_amdgcn_readfirstlane(t_ >> 6); } \
    unsigned char* ws = ka->ws; F.ws = ws; F.ctl = (gu32*)(ws + WS_CTL); bf16* HN = (bf16*)(ws + WS_HN); unsigned char* A = ws + WS_A; float* H = ka->out; (void)HN; (void)A; (void)H
    int lo, hi;
    { ENTER();
      for (int u = F.tid; u < (LDS_BYTES - LDSCTL_OFF) / 4; u += NWAVES * 64) ((LAS unsigned*)(F.lds + LDSCTL_OFF))[u] = 0u;
      lo = ka->ph_lo; hi = ka->ph_hi; }
    __syncthreads();
    XcdBarrier bar; bar.bar = nullptr; bar.x = 0; bar.st = nullptr;
    if (N_LAUNCHES == 1) { ENTER(); bar = xcd_barrier_post((unsigned*)(F.ctl + CW_BAR), F.MISC + 8); }
#define GRID_BAR() do { if (N_LAUNCHES == 1) xcd_barrier(bar); } while (0)
#define IN(k) (lo <= (k) && (k) < hi)
#define BOTH(k) (IN(k) && IN((k) + 1))

    if (IN(0)) { ENTER(); if (EN_P0) p0_prologue(F, ka);
#ifdef PROBE_DUP_P0
        __syncthreads(); p0_prologue(F, ka);
#endif
        if (BOTH(0)) GRID_BAR(); }

    for (int l = 0; l < 2; ++l) {
        const int pb = 1 + 12 * l;
        if (IN(pb + 0) && l == 0) { ENTER(); if (EN_NORM1) norm_phase<false>(F, ka->in[0], ka->in[2], HN); if (BOTH(pb + 0)) GRID_BAR(); }
        if (IN(pb + 1)) {
            if (EN_INPROJ) { ENTER(); const int rb_ = l == 0 ? 0 : prep_rstd(F, (const float*)(ws + WS_PART) + 2 * M * 32); pg8::Gemm g{HN, (const bf16*)(ws + WS_WIN) + (size_t)l * NIN * D, M, NIN, D}; pg8::StaticOrder S; S.init(M, NIN, F.G, (int)blockIdx.x);
              pg8::EpiInProj E{(bf16*)(A + A_QH), (bf16*)(A + A_KH), (bf16*)(A + A_VH), (bf16*)(A + A_GATE), (bf16*)(A + A_QG), (bf16*)(A + A_KG), (bf16*)(A + A_VG), (float*)(A + A_GH), (float*)(A + A_GG),
                                (const float*)(ws + WS_SMALL + SM_LB) + l * 1024, (const float*)(ws + WS_SMALL + SM_L1M) + l * 1024, ka->in[7] + l * 512,
                                l == 0 ? nullptr : (const LAS float*)(F.lds + RSTD_OFF), rb_};
              pg8::gemm_phase<pg8::EpiInProj, pg8::StaticOrder, PG8_ALIGN, PG8_SP2>(F.lds + RING_OFF, g, S, E); }
            if (EN_PP) { ENTER(); pg8::Gemm g{(const bf16*)(ws + WS_PB) + (size_t)l * M * PLE, (const bf16*)(ws + WS_WPP) + (size_t)l * D * PLE, M, D, PLE}; pg8::StaticOrder S; S.init(M, D, F.G, (int)blockIdx.x);
              pg8::EpiPlainBf16 E{(bf16*)(ws + WS_PP), D};
              pg8::gemm_phase<pg8::EpiPlainBf16, pg8::StaticOrder, PG8_ALIGN, PG8_SP2>(F.lds + RING_OFF, g, S, E); }
            if (BOTH(pb + 1)) GRID_BAR(); }
        if (IN(pb + 2)) { ENTER(); if (EN_MIX) mixpre_phase(F);
#ifdef PROBE_DUP_PRE
            mixpre_phase(F);
#endif
            if (BOTH(pb + 2)) GRID_BAR(); }
        if (IN(pb + 3)) { ENTER(); if (EN_MIX) mixseq_phase(F);
#ifdef PROBE_DUP_SEQ
            mixseq_phase(F);
#endif
            if (BOTH(pb + 3)) GRID_BAR(); }
        if (IN(pb + 4)) { ENTER(); if (EN_POST) postmix_phase(F, (const float*)(A + A_ORAW), (const bf16*)(A + A_GATE), ka->in[5] + l * 1024, ka->in[8] + l * 1024, (bf16*)(A + A_O)); if (BOTH(pb + 4)) GRID_BAR(); }
        if (IN(pb + 5)) { ENTER(); if (EN_OUT) { pg8::Gemm g{(const bf16*)(A + A_O), (const bf16*)(ws + WS_WOUT) + (size_t)l * D * D, M, D, D}; pg8::StaticOrder S; S.init(M, D, F.G, (int)blockIdx.x);
            pg8::EpiResid E{l == 0 ? ka->in[0] : H, H, D, 1.0f, l == 0 ? HN : nullptr, l == 0 ? (float*)(ws + WS_PART) : nullptr};
            pg8::gemm_phase<pg8::EpiResid, pg8::StaticOrder, PG8_ALIGN, PG8_SP2>(F.lds + RING_OFF, g, S, E); }
            if (BOTH(pb + 5)) GRID_BAR(); }
        if (IN(pb + 6)) { ENTER(); if (EN_NORM2 && l == 1) norm_router_phase(F, H, ka->in[10] + l * D, ka->in[14], (unsigned char*)HN);
            if (BOTH(pb + 6) && l == 1) GRID_BAR(); }
        if (l == 0) {
            if (IN(pb + 8)) { ENTER(); if (EN_FUP) { pg8::Gemm g{HN, (const bf16*)(ws + WS_WGU), M, 2 * FFN, D}; pg8::StaticOrder S; S.init(M, 2 * FFN, F.G, (int)blockIdx.x);
                const int rb_ = prep_rstd(F, (const float*)(ws + WS_PART)); pg8::EpiSwiGLU E{(bf16*)A, FFN, 1 << 20, (const LAS float*)(F.lds + RSTD_OFF), rb_};
                pg8::gemm_phase<pg8::EpiSwiGLU, pg8::StaticOrder, PG8_ALIGN, PG8_SP2>(F.lds + RING_OFF, g, S, E); }
                if (BOTH(pb + 8)) GRID_BAR(); }
            if (IN(pb + 9)) { ENTER(); if (EN_FDN) { pg8::Gemm g{(const bf16*)A, (const bf16*)(ws + WS_WD), M, D, FFN}; pg8::StaticOrder S; S.init(M, D, F.G, (int)blockIdx.x);
                pg8::EpiResid E{H, H, D, 1.0f, (bf16*)(A + A_O), (float*)(ws + WS_PART) + M * 32};
                pg8::gemm_phase<pg8::EpiResid, pg8::StaticOrder, PG8_ALIGN, PG8_SP2>(F.lds + RING_OFF, g, S, E); }
                if (BOTH(pb + 9)) GRID_BAR(); }
        } else {
            if (IN(pb + 7)) { ENTER(); if (EN_SCAT) moe_scatter_phase(F, (const unsigned char*)HN, ws + WS_XS); if (BOTH(pb + 7)) GRID_BAR(); }
            if (IN(pb + 8)) { ENTER(); if (EN_MUP) { pg8::Gemm g{(const bf16*)(ws + WS_XS), (const bf16*)(ws + WS_MGU), CAP, 2 * EFF * NEXP, D / 2}; pg8::MoeOrder S; S.init((const int*)(ws + WS_SMALL + SM_PSTART), 2 * EFF / 256, F.G, (int)blockIdx.x);
                pg8::EpiSwiGLU8 E{A, EFF, 2 * EFF / 256, 1.0f / (pg8::F8_SA * pg8::F8_SWU), pg8::F8_SM};
                pg8::gemm_phase<pg8::EpiSwiGLU8, pg8::MoeOrder, PG8_ALIGN, PG8_SP2, true>(F.lds + RING_OFF, g, S, E); }
                if (BOTH(pb + 8)) GRID_BAR(); }
            if (IN(pb + 9)) { ENTER(); if (EN_MDN) { pg8::Gemm g{(const bf16*)A, (const bf16*)(ws + WS_MD), CAP, D * NEXP, EFF / 2}; pg8::MoeOrder S; S.init((const int*)(ws + WS_SMALL + SM_PSTART), D / 256, F.G, (int)blockIdx.x);
                pg8::EpiMoeDown E{(bf16*)(ws + WS_XS), D, D / 256, (const float*)(ws + WS_SMALL + SM_SLOTW), 1.0f / (pg8::F8_SM * pg8::F8_SWD)};
                pg8::gemm_phase<pg8::EpiMoeDown, pg8::MoeOrder, PG8_ALIGN, PG8_SP2, true>(F.lds + RING_OFF, g, S, E); }
                if (BOTH(pb + 9)) GRID_BAR(); }
            if (IN(pb + 10)) { ENTER(); if (EN_COMB) combine_norm_phase(F, H, (const bf16*)(ws + WS_XS), ka->in[18] + l * D, HN); if (BOTH(pb + 10)) GRID_BAR(); }
        }
        if (IN(pb + 11)) { ENTER(); if (EN_PLE) { pg8::StaticOrder S; S.init(M, D, F.G, (int)blockIdx.x);
            if (l == 0) { pg8::Gemm g{(const bf16*)(A + A_O), (const bf16*)(ws + WS_WPG), M, D, D};
                const int rb_ = prep_rstd(F, (const float*)(ws + WS_PART) + M * 32);
                pg8::EpiPle E{H, (const bf16*)(ws + WS_PP), D, 1.0f, (const LAS float*)(F.lds + RSTD_OFF), rb_, HN, (float*)(ws + WS_PART) + 2 * M * 32};
                pg8::gemm_phase<pg8::EpiPle, pg8::StaticOrder, PG8_ALIGN, PG8_SP2>(F.lds + RING_OFF, g, S, E); }
            else { pg8::Gemm g{HN, (const bf16*)(ws + WS_WPG + 8 * MiB), M, D, D / 2}; pg8::EpiPle E{H, (const bf16*)(ws + WS_PP), D, 1.0f / (pg8::F8_SA * pg8::F8_SWU), nullptr, 0, nullptr, nullptr};
                pg8::gemm_phase<pg8::EpiPle, pg8::StaticOrder, PG8_ALIGN, PG8_SP2, true>(F.lds + RING_OFF, g, S, E); } }
            if (BOTH(pb + 11)) GRID_BAR(); }
    }
    if (IN(25)) { ENTER(); if (EN_FIN) final_norm_phase(F, H, ka->in[21]); }
#undef IN
#undef BOTH
#undef GRID_BAR
}

extern "C" void kernel_launch(void* const* d_in, const int* in_sizes, int n_in, void* d_out, int out_size, void* d_ws, size_t ws_size, hipStream_t stream) {
    static int grid = 0;
    if (grid == 0) {
        if (n_in != 22 || in_sizes[0] != M * D || out_size != M * D || ws_size < WS_END) { fprintf(stderr, "kernel_launch: shape/workspace mismatch: n_in %d in0 %d out %d ws %zu (need %zu)\n", n_in, n_in > 0 ? in_sizes[0] : -1, out_size, ws_size, (size_t)WS_END); grid = -1; return; }
        int dev = 0, cus = 0, per_cu = 0;
        if (hipGetDevice(&dev) != hipSuccess || hipDeviceGetAttribute(&cus, hipDeviceAttributeMultiprocessorCount, dev) != hipSuccess) { fprintf(stderr, "kernel_launch: device query failed\n"); grid = -1; return; }
        if (hipFuncSetAttribute((const void*)hymba_fwd, hipFuncAttributeMaxDynamicSharedMemorySize, LDS_BYTES) != hipSuccess) { fprintf(stderr, "kernel_launch: hipFuncSetAttribute failed\n"); grid = -1; return; }
        if (hipOccupancyMaxActiveBlocksPerMultiprocessor(&per_cu, (const void*)hymba_fwd, NWAVES * 64, LDS_BYTES) != hipSuccess || per_cu < 1)
            fprintf(stderr, "kernel_launch: note: occupancy query reports %d workgroups per CU\n", per_cu);
        (void)hipGetLastError();
        grid = cus;
    }
    if (grid < 0) return;
    if (hipMemsetAsync((char*)d_ws + WS_CTL, 0, CTL_ZERO_BYTES, stream) != hipSuccess) { fprintf(stderr, "kernel_launch: memset failed\n"); return; }
    Args a{};
    for (int i = 0; i < 22; ++i) a.in[i] = (const float*)d_in[i];
    a.out = (float*)d_out; a.ws = (unsigned char*)d_ws; a.pad = 0;
#ifndef DIAG_LAST
#define DIAG_LAST (N_PHASES - 1)
#endif
    for (int li = 0; li < N_LAUNCHES && li <= DIAG_LAST; ++li) {
        a.ph_lo = (N_LAUNCHES == 1) ? 0 : li; a.ph_hi = (N_LAUNCHES == 1) ? N_PHASES : li + 1; a.li = li;
        hipLaunchKernelGGL(hymba_fwd, dim3(grid), dim3(NWAVES * 64), LDS_BYTES, stream, a);
        const hipError_t le = hipPeekAtLastError();
        if (le != hipSuccess) { fprintf(stderr, "kernel_launch: launch %d failed: %s\n", li, hipGetErrorName(le)); break; }
    }
#ifdef DIAG_DUMP_OFF
    (void)hipMemcpyAsync(d_out, (char*)d_ws + DIAG_DUMP_OFF, (size_t)DIAG_DUMP_BYTES, hipMemcpyDeviceToDevice, stream);
#endif
}
```

```cpp
#include <hip/hip_runtime.h>
#include <cstdio>
#include <cstdint>
namespace pg8 {
#define PG8_LAS __attribute__((address_space(3)))
typedef unsigned short bf16_t;
typedef short bf16x8 __attribute__((ext_vector_type(8)));
typedef float f32x4 __attribute__((ext_vector_type(4)));
typedef unsigned u32x4 __attribute__((ext_vector_type(4)));
constexpr int BM = 256, BK = 64, HALF = 128, HTB = HALF * BK * 2  , STAGE_BYTES = 8 * HTB, NXCD = 8, WGM = 8;

__host__ __device__ __forceinline__ int lds_byte(int r, int c) { const int st = (r >> 4) * 2 + (c >> 5), rr = r & 15, cc = c & 31, ob = rr * 64 + cc * 2; return st * 1024 + (ob ^ (((ob >> 9) & 1) << 5)); }
__host__ __device__ __forceinline__ void stage_rc(int b, int& R, int& C) { const int st = b / 1024, sb = b % 1024, swz = sb ^ (((sb >> 9) & 1) << 5); R = (st >> 1) * 16 + swz / 64; C = (st & 1) * 32 + (swz % 64) / 2; }
__host__ __device__ __forceinline__ int perm32(int rho) { const int n = rho >> 4, i = rho & 15; return 8 * (i >> 2) + 4 * n + (i & 3); }

struct Unit { int pm, pn; };
struct Gemm { const bf16_t* A; const bf16_t* Bt; int M, N, K; };

struct StaticOrder {
    int nM, nN, nwg, G, c;
    __host__ __device__ void init(int M, int N, int G_, int c_) { nM = M / BM; nN = N / BM; nwg = nM * nN; G = G_; c = c_; }
    __host__ __device__ bool next(int i, Unit& u) const {
        const long L = (long)i * G + c; if (L >= nwg) return false;
        int wgid = (int)L; { const int q = nwg / NXCD, r = nwg % NXCD, xcd = wgid % NXCD, off = wgid / NXCD; wgid = (xcd < r ? xcd * (q + 1) : r * (q + 1) + (xcd - r) * q) + off; }
        const int nig = WGM * nN, gid = wgid / nig, fm = gid * WGM, gsz = (nM - fm) < WGM ? (nM - fm) : WGM;
        u.pm = fm + ((wgid % nig) % gsz); u.pn = (wgid % nig) / gsz; return true;
    }
    __device__ __forceinline__ void a_ready(const Unit&) const {}
    __device__ __forceinline__ void done(const Unit&) const {}
};

typedef int i32x4c __attribute__((ext_vector_type(4)));
typedef float f32x2c __attribute__((ext_vector_type(2)));
typedef __bf16 bf16x2c __attribute__((ext_vector_type(2)));
__device__ __forceinline__ unsigned cvt_pk_bf16(float lo, float hi) { const f32x2c v = {lo, hi}; const bf16x2c r = __builtin_convertvector(v, bf16x2c); return __builtin_bit_cast(unsigned, r); }
typedef float f32x2 __attribute__((ext_vector_type(2)));
__device__ __forceinline__ void glds16_s(const char* base, unsigned voff, unsigned lds_dst) {
    unsigned keep;
    asm volatile("s_mov_b32 %0, m0\n\ts_mov_b32 m0, %3\n\ts_nop 0\n\tglobal_load_lds_dwordx4 %1, %2\n\ts_mov_b32 m0, %0" : "=&s"(keep) : "v"(voff), "s"(base), "s"(lds_dst) : "memory");
}
__device__ __forceinline__ float ex(float x) { return __builtin_amdgcn_exp2f(x * 1.44269504089f); }
__device__ __forceinline__ float lg(float x) { return __log2f(x) * 0.69314718056f; }
__device__ __forceinline__ float sigm(float z) { return __builtin_amdgcn_rcpf(1.0f + ex(-z)); }
__device__ __forceinline__ float logsig(float z) { return fminf(z, 0.f) - lg(1.0f + ex(-fabsf(z))); }
__device__ __forceinline__ float bf_lo(unsigned u) { return __uint_as_float(u << 16); }
__device__ __forceinline__ float bf_hi(unsigned u) { return __uint_as_float(u & 0xffff0000u); }
typedef unsigned u32x2 __attribute__((ext_vector_type(2)));

__device__ __forceinline__ float rstd_of(const PG8_LAS float* rt, int rbase, int row) { return rt ? rt[row - rbase] : 1.0f; }
enum { TY_ID = 0, TY_SILU = 1, TY_SIG = 2, TY_SCALE = 3, TY_HF = 4, TY_LA = 5 };
struct EpiInProj {
    static constexpr bool PERM = true, AFTER_DRAIN = false;
    bf16_t *QH, *KH, *VH, *GATE, *QG, *KG, *VG; float *GH;
    const float *lb, *l1m;
    const PG8_LAS float* rt; int rbase;
    template <int TY> __device__ __forceinline__ void run(const f32x4 (&acc)[2][2][4][2], int row0, bf16_t* ob, float* of, int ld, int cb, int cc, int fq) const {
        float pa[2][8], pb[2][8];
#pragma unroll
        for (int bj = 0; bj < 2; ++bj)
#pragma unroll
            for (int i = 0; i < 8; ++i) { pa[bj][i] = 0.f; pb[bj][i] = 0.f;
                if (TY == TY_HF) { pa[bj][i] = lb[cc + bj * HALF + i]; pb[bj][i] = l1m[cc + bj * HALF + i]; }
                }
#pragma unroll
        for (int ai = 0; ai < 2; ++ai)
#pragma unroll
            for (int m = 0; m < 4; ++m) { const size_t ro = (size_t)(row0 + ai * HALF + m * 16) * ld + cb; const float rs_ = rstd_of(rt, rbase, row0 + ai * HALF + m * 16);
#pragma unroll
                for (int bj = 0; bj < 2; ++bj) { const f32x4 v0 = acc[ai][bj][m][0] * rs_, v1 = acc[ai][bj][m][1] * rs_;
                    float z[8] = {v0[0], v0[1], v0[2], v0[3], v1[0], v1[1], v1[2], v1[3]}; float y[8];
                    if (TY == TY_HF) { float lf[8];
#pragma unroll
                        for (int i = 0; i < 8; ++i) { const float a = pb[bj][i] + logsig(z[i]); lf[i] = pa[bj][i] > 0.f ? lg(pa[bj][i] + ex(a)) : a;
                            y[i] = (1.0f - pa[bj][i]) * __builtin_amdgcn_rcpf(1.0f + ex(z[i])); }
                        *(f32x4*)(of + ro + bj * HALF) = (f32x4){lf[0], lf[1], lf[2], lf[3]}; *(f32x4*)(of + ro + bj * HALF + 4) = (f32x4){lf[4], lf[5], lf[6], lf[7]};
                    } else if (TY == TY_LA) {
#pragma unroll
                        for (int i = 0; i < 8; ++i) y[i] = logsig(z[i] + pa[bj][i]) * 0.0625f;
                        *(f32x4*)(of + ro + bj * HALF) = (f32x4){y[0], y[1], y[2], y[3]}; *(f32x4*)(of + ro + bj * HALF + 4) = (f32x4){y[4], y[5], y[6], y[7]};
                    } else {
#pragma unroll
                        for (int i = 0; i < 8; ++i) { if (TY == TY_ID) y[i] = z[i]; if (TY == TY_SILU) y[i] = z[i] * sigm(z[i]); if (TY == TY_SIG) y[i] = sigm(z[i]); if (TY == TY_SCALE) y[i] = z[i] * 0.08838834764831845f; }
                    }
                    if (TY != TY_LA) { u32x4 w; w.x = cvt_pk_bf16(y[0], y[1]); w.y = cvt_pk_bf16(y[2], y[3]); w.z = cvt_pk_bf16(y[4], y[5]); w.w = cvt_pk_bf16(y[6], y[7]);
                        *(u32x4*)(ob + ro + bj * HALF) = w; } } }
    }
    __device__ __forceinline__ void operator()(const f32x4 (&acc)[2][2][4][2], const Unit& u, int wr, int wc, int fr, int fq) const {
        const int pn = u.pn, row0 = u.pm * BM + wr * 64 + fr, cw = wc * 32 + 8 * fq;
        if (pn < 4)       run<TY_SILU>(acc, row0, QH, nullptr, 1024, pn * 256 + cw, 0, fq);
        else if (pn < 8)  run<TY_HF>(acc, row0, KH, GH, 1024, (pn - 4) * 256 + cw, (pn - 4) * 256 + cw, fq);
        else if (pn < 12) run<TY_ID>(acc, row0, VH, nullptr, 1024, (pn - 8) * 256 + cw, 0, fq);
        else if (pn < 16) run<TY_SIG>(acc, row0, GATE, nullptr, 2048, (pn - 12) * 256 + cw, 0, fq);
        else if (pn < 18) run<TY_SCALE>(acc, row0, QG, nullptr, 512, (pn - 16) * 256 + cw, 0, fq);
        else if (pn < 20) run<TY_ID>(acc, row0, KG, nullptr, 512, (pn - 18) * 256 + cw, 0, fq);
        else if (pn < 24) run<TY_ID>(acc, row0, VG, nullptr, 1024, (pn - 20) * 256 + cw, 0, fq);
        else              run<TY_SILU>(acc, row0, GATE, nullptr, 2048, 1024 + (pn - 24) * 256 + cw, 0, fq);
    }
};
struct EpiPlainBf16 {
    static constexpr bool PERM = true, AFTER_DRAIN = false;
    bf16_t* O; int ldc;
    __device__ __forceinline__ void operator()(const f32x4 (&acc)[2][2][4][2], const Unit& u, int wr, int wc, int fr, int fq) const {
        const int row0 = u.pm * BM + wr * 64 + fr, col0 = u.pn * BM + wc * 32 + 8 * fq;
#pragma unroll
        for (int ai = 0; ai < 2; ++ai)
#pragma unroll
            for (int m = 0; m < 4; ++m) { bf16_t* rowp = O + (size_t)(row0 + ai * HALF + m * 16) * ldc + col0;
#pragma unroll
                for (int bj = 0; bj < 2; ++bj) { const f32x4 v0 = acc[ai][bj][m][0], v1 = acc[ai][bj][m][1];
                    u32x4 w; w.x = cvt_pk_bf16(v0[0], v0[1]); w.y = cvt_pk_bf16(v0[2], v0[3]); w.z = cvt_pk_bf16(v1[0], v1[1]); w.w = cvt_pk_bf16(v1[2], v1[3]);
                    *(u32x4*)(rowp + bj * HALF) = w; } }
    }
};
struct EpiSwiGLU {
    static constexpr bool PERM = true, AFTER_DRAIN = false;
    bf16_t* O; int ldc; int nNe; const PG8_LAS float* rt; int rbase;
    __device__ __forceinline__ void operator()(const f32x4 (&acc)[2][2][4][2], const Unit& u, int wr, int wc, int fr, int fq) const {
        const int pnl = u.pn - (u.pn / nNe) * nNe;
        const int row0 = u.pm * BM + wr * 64 + fr, col0 = pnl * HALF + wc * 32 + 8 * fq;
#pragma unroll
        for (int ai = 0; ai < 2; ++ai)
#pragma unroll
            for (int m = 0; m < 4; ++m) { bf16_t* rowp = O + (size_t)(row0 + ai * HALF + m * 16) * ldc + col0;
                const float rs_ = rstd_of(rt, rbase, row0 + ai * HALF + m * 16);
                const f32x4 g0 = acc[ai][0][m][0] * rs_, g1 = acc[ai][0][m][1] * rs_, u0 = acc[ai][1][m][0] * rs_, u1 = acc[ai][1][m][1] * rs_;
                float y[8];
#pragma unroll
                for (int i = 0; i < 4; ++i) { y[i] = g0[i] * sigm(g0[i]) * u0[i]; y[4 + i] = g1[i] * sigm(g1[i]) * u1[i]; }
                u32x4 w; w.x = cvt_pk_bf16(y[0], y[1]); w.y = cvt_pk_bf16(y[2], y[3]); w.z = cvt_pk_bf16(y[4], y[5]); w.w = cvt_pk_bf16(y[6], y[7]);
                *(u32x4*)rowp = w; }
    }
};
struct EpiResid {
    static constexpr bool PERM = false, AFTER_DRAIN = false;
    const float* base; float* out; int ldc; float sc; bf16_t* hb; float* rowss;
    __device__ __forceinline__ void operator()(const f32x4 (&acc)[2][2][4][2], const Unit& u, int wr, int wc, int fr, int fq) const {
        const int row0 = u.pm * BM + wr * 64 + fr, col0 = u.pn * BM + wc * 32 + 4 * fq;
        bf16_t* hb_ = hb; float* rss_ = rowss; asm volatile("" : "+s"(hb_), "+s"(rss_));
#pragma unroll
        for (int ai = 0; ai < 2; ++ai)
#pragma unroll
            for (int m = 0; m < 4; ++m) { const unsigned off = (unsigned)(row0 + ai * HALF + m * 16) * (unsigned)ldc + (unsigned)col0;
                f32x4 bs[2][2];
#pragma unroll
                for (int bj = 0; bj < 2; ++bj)
#pragma unroll
                    for (int n = 0; n < 2; ++n) bs[bj][n] = *(const f32x4*)(base + off + bj * HALF + n * 16);
                float ss = 0.f;
#pragma unroll
                for (int bj = 0; bj < 2; ++bj)
#pragma unroll
                    for (int n = 0; n < 2; ++n) { const f32x4 o = bs[bj][n] + acc[ai][bj][m][n] * sc; *(f32x4*)(out + off + bj * HALF + n * 16) = o;
                        if (hb_) { u32x2 w; w.x = cvt_pk_bf16(o[0], o[1]); w.y = cvt_pk_bf16(o[2], o[3]); *(u32x2*)(hb_ + off + bj * HALF + n * 16) = w; ss += (o[0] * o[0] + o[1] * o[1]) + (o[2] * o[2] + o[3] * o[3]); } }
                if (hb_) { ss += __shfl_xor(ss, 16); ss += __shfl_xor(ss, 32); if (fq == 0) rss_[(unsigned)(row0 + ai * HALF + m * 16) * 32u + (unsigned)(u.pn * 4 + wc)] = ss; }
                if (m & 1) asm volatile("" ::: "memory"); }
    }
};
struct EpiPle {
    static constexpr bool PERM = false, AFTER_DRAIN = false;
    float* H; const bf16_t* PP; int ldc; float sc; const PG8_LAS float* rt; int rbase; bf16_t* hb; float* rout;
    __device__ __forceinline__ void operator()(const f32x4 (&acc)[2][2][4][2], const Unit& u, int wr, int wc, int fr, int fq) const {
        const int row0 = u.pm * BM + wr * 64 + fr, col0 = u.pn * BM + wc * 32 + 4 * fq;
        bf16_t* hb_ = hb; float* rss_ = rout; asm volatile("" : "+s"(hb_), "+s"(rss_));
#pragma unroll
        for (int ai = 0; ai < 2; ++ai)
#pragma unroll
            for (int m = 0; m < 4; ++m) { const unsigned off = (unsigned)(row0 + ai * HALF + m * 16) * (unsigned)ldc + (unsigned)col0; const float rs_ = sc * rstd_of(rt, rbase, row0 + ai * HALF + m * 16);
                f32x4 bs[2][2]; u32x2 pp[2][2];
#pragma unroll
                for (int bj = 0; bj < 2; ++bj)
#pragma unroll
                    for (int n = 0; n < 2; ++n) { bs[bj][n] = *(const f32x4*)(H + off + bj * HALF + n * 16); pp[bj][n] = *(const u32x2*)(PP + off + bj * HALF + n * 16); }
                float ss = 0.f;
#pragma unroll
                for (int bj = 0; bj < 2; ++bj)
#pragma unroll
                    for (int n = 0; n < 2; ++n) { const f32x4 a = acc[ai][bj][m][n] * rs_; const u32x2 p = pp[bj][n];
                        f32x4 o = bs[bj][n]; o[0] += sigm(a[0]) * bf_lo(p.x); o[1] += sigm(a[1]) * bf_hi(p.x); o[2] += sigm(a[2]) * bf_lo(p.y); o[3] += sigm(a[3]) * bf_hi(p.y);
                        *(f32x4*)(H + off + bj * HALF + n * 16) = o;
                        if (hb_) { u32x2 w; w.x = cvt_pk_bf16(o[0], o[1]); w.y = cvt_pk_bf16(o[2], o[3]); *(u32x2*)(hb_ + off + bj * HALF + n * 16) = w; ss += (o[0] * o[0] + o[1] * o[1]) + (o[2] * o[2] + o[3] * o[3]); } }
                if (hb_) { ss += __shfl_xor(ss, 16); ss += __shfl_xor(ss, 32); if (fq == 0) rss_[(unsigned)(row0 + ai * HALF + m * 16) * 32u + (unsigned)(u.pn * 4 + wc)] = ss; }
                if (m & 1) asm volatile("" ::: "memory"); }
    }
};
struct EpiMoeDown {
    static constexpr bool PERM = true, AFTER_DRAIN = false;
    bf16_t* O; int ldc; int nNe; const float* sw; float sc;
    __device__ __forceinline__ void operator()(const f32x4 (&acc)[2][2][4][2], const Unit& u, int wr, int wc, int fr, int fq) const {
        const int pnl = u.pn - (u.pn / nNe) * nNe;
        const int row0 = u.pm * BM + wr * 64 + fr, col0 = pnl * BM + wc * 32 + 8 * fq;
#pragma unroll
        for (int ai = 0; ai < 2; ++ai)
#pragma unroll
            for (int m = 0; m < 4; ++m) { const int row = row0 + ai * HALF + m * 16; const float s = sw[row] * sc; bf16_t* rowp = O + (size_t)row * ldc + col0;
#pragma unroll
                for (int bj = 0; bj < 2; ++bj) { const f32x4 v0 = acc[ai][bj][m][0] * s, v1 = acc[ai][bj][m][1] * s;
                    u32x4 w; w.x = cvt_pk_bf16(v0[0], v0[1]); w.y = cvt_pk_bf16(v0[2], v0[3]); w.z = cvt_pk_bf16(v1[0], v1[1]); w.w = cvt_pk_bf16(v1[2], v1[3]);
                    *(u32x4*)(rowp + bj * HALF) = w; } }
    }
};
constexpr float F8_SA = 16.0f, F8_SWU = 256.0f, F8_SM = 4.0f, F8_SWD = 512.0f;
__device__ __forceinline__ float clamp8(float x) { return __builtin_amdgcn_fmed3f(x, -448.0f, 448.0f); }
__device__ __forceinline__ unsigned pk4_fp8(float a, float b, float c, float d) { int p = 0; p = __builtin_amdgcn_cvt_pk_fp8_f32(clamp8(a), clamp8(b), p, false); p = __builtin_amdgcn_cvt_pk_fp8_f32(clamp8(c), clamp8(d), p, true); return (unsigned)p; }
struct EpiSwiGLU8 {
    static constexpr bool PERM = true, AFTER_DRAIN = false;
    unsigned char* O; int ldc; int nNe; float sin, sout;
    __device__ __forceinline__ void operator()(const f32x4 (&acc)[2][2][4][2], const Unit& u, int wr, int wc, int fr, int fq) const {
        const int pnl = u.pn - (u.pn / nNe) * nNe;
        const int row0 = u.pm * BM + wr * 64 + fr, col0 = pnl * HALF + wc * 32 + 8 * fq;
#pragma unroll
        for (int ai = 0; ai < 2; ++ai)
#pragma unroll
            for (int m = 0; m < 4; ++m) { unsigned char* rowp = O + (size_t)(row0 + ai * HALF + m * 16) * ldc + col0;
                const f32x4 g0 = acc[ai][0][m][0] * sin, g1 = acc[ai][0][m][1] * sin, u0 = acc[ai][1][m][0] * sin, u1 = acc[ai][1][m][1] * sin;
                float y[8];
#pragma unroll
                for (int i = 0; i < 4; ++i) { y[i] = g0[i] * sigm(g0[i]) * u0[i] * sout; y[4 + i] = g1[i] * sigm(g1[i]) * u1[i] * sout; }
                u32x2 w; w.x = pk4_fp8(y[0], y[1], y[2], y[3]); w.y = pk4_fp8(y[4], y[5], y[6], y[7]);
                *(u32x2*)rowp = w; }
    }
};
struct MoeOrder {
    int nNe, G, c, P, nwg; int ps[9];
    __device__ __forceinline__ void init(const int* pstart, int nNe_, int G_, int c_) {
#pragma unroll
        for (int i = 0; i < 9; ++i) ps[i] = __builtin_amdgcn_readfirstlane(pstart[i]);
        nNe = nNe_; G = G_; c = c_; P = ps[8] / BM; nwg = P * nNe; }
    __device__ __forceinline__ bool next(int i, Unit& u) const {
        const long L = (long)i * G + c; if (L >= nwg) return false;
        int wgid = (int)L; { const int q = nwg / NXCD, r = nwg % NXCD, xcd = wgid % NXCD, off = wgid / NXCD; wgid = (xcd < r ? xcd * (q + 1) : r * (q + 1) + (xcd - r) * q) + off; }
        const int nig = WGM * nNe, gid = wgid / nig, fm = gid * WGM, gsz = (P - fm) < WGM ? (P - fm) : WGM;
        const int pm = fm + ((wgid % nig) % gsz), pnl = (wgid % nig) / gsz;
        int e = 0;
#pragma unroll
        for (int k = 1; k < 8; ++k) e += (pm * BM >= ps[k]) ? 1 : 0;
        u.pm = pm; u.pn = e * nNe + pnl; return true;
    }
    __device__ __forceinline__ void a_ready(const Unit&) const {}
    __device__ __forceinline__ void done(const Unit&) const {}
};


template <class Epi, class Sched, bool ALIGN_EPI = false, bool SP2 = false, bool F8 = false>
__device__ __forceinline__ void gemm_phase(PG8_LAS unsigned char* lds, const Gemm g, const Sched& S, const Epi& E) {
    int tid_ = threadIdx.x; asm volatile("" : "+v"(tid_));
    const int tid = tid_, wid = __builtin_amdgcn_readfirstlane(tid >> 6), lane = tid & 63, wr = wid >> 2, wc = wid & 3, fr = lane & 15, fq = lane >> 4;
    const int K = g.K, nt = K / BK;
    unsigned voffA[2], voffB[2];
#pragma unroll
    for (int i = 0; i < 2; ++i) { int R, C; stage_rc(tid * 16 + i * 8192, R, C); const int Rb = Epi::PERM ? ((R & ~31) + perm32(R & 31)) : R;
        voffA[i] = (unsigned)(R * K + C) * 2u; voffB[i] = (unsigned)(Rb * K + C) * 2u; }
    const size_t kstep = (size_t)(BK * 2);
    const size_t hstep = (size_t)HALF * K * 2;
    const size_t tstep = 2 * hstep;
    const unsigned ldsbase = (unsigned)(size_t)lds;
    const unsigned ldsw = (unsigned)wid * 1024u;
    const int aoff = lds_byte(wr * 64 + fr, fq * 8), boff = lds_byte(wc * 32 + fr, fq * 8);
#define PG8_SA(b, h) (((b) * 2 + (h)) * HTB)
#define PG8_SB(b, h) ((4 + (b) * 2 + (h)) * HTB)
#define PG8_STAGE(bufoff, gbase, voff) do { _Pragma("unroll") for (int _i = 0; _i < 2; ++_i) \
        glds16_s((const char*)(gbase), (voff)[_i], ldsbase + (unsigned)((bufoff) + _i * 8192) + ldsw); } while (0)
#define PG8_LDA(dst, b, h) do { _Pragma("unroll") for (int m = 0; m < 4; ++m) _Pragma("unroll") for (int k = 0; k < 2; ++k) dst[m][k] = *(const PG8_LAS bf16x8*)(lds + PG8_SA(b, h) + aoff + m * 2048 + k * 1024); } while (0)
#define PG8_LDB(dst, b, h) do { _Pragma("unroll") for (int n = 0; n < 2; ++n) _Pragma("unroll") for (int k = 0; k < 2; ++k) dst[n][k] = *(const PG8_LAS bf16x8*)(lds + PG8_SB(b, h) + boff + n * 2048 + k * 1024); } while (0)
#define PG8_CAT8(x, y) __builtin_shufflevector(__builtin_bit_cast(i32x4c, (x)), __builtin_bit_cast(i32x4c, (y)), 0, 1, 2, 3, 4, 5, 6, 7)
#define PG8_MMA(ai, bj, At, Bt) do { __builtin_amdgcn_s_setprio(1); \
        if constexpr (F8) { _Pragma("unroll") for (int m = 0; m < 4; ++m) _Pragma("unroll") for (int n = 0; n < 2; ++n) \
            asm volatile("v_mfma_scale_f32_16x16x128_f8f6f4 %0, %1, %2, %0, %3, %3 op_sel_hi:[0,0,0]" : "+v"(acc[ai][bj][m][n]) : "v"(PG8_CAT8(Bt[n][0], Bt[n][1])), "v"(PG8_CAT8(At[m][0], At[m][1])), "v"(sc7f)); } \
        else { _Pragma("unroll") for (int m = 0; m < 4; ++m) _Pragma("unroll") for (int n = 0; n < 2; ++n) _Pragma("unroll") for (int k = 0; k < 2; ++k) \
            acc[ai][bj][m][n] = __builtin_amdgcn_mfma_f32_16x16x32_bf16(Bt[n][k], At[m][k], acc[ai][bj][m][n], 0, 0, 0); } \
        __builtin_amdgcn_s_setprio(0); } while (0)
#define PG8_WAIT_V(n) asm volatile("s_waitcnt vmcnt(" #n ")" ::: "memory")
#define PG8_WAIT_L(n) asm volatile("s_waitcnt lgkmcnt(" #n ")" ::: "memory")
#define PG8_BAR __builtin_amdgcn_s_barrier()
#define PG8_SCHED __builtin_amdgcn_sched_barrier(0)
    int sc7f = 0x7F7F7F7F; asm volatile("" : "+v"(sc7f));
    Unit cur, nxt; int ui = 0;
    if (!S.next(0, cur)) return;
    f32x4 acc[2][2][4][2];
#pragma unroll
    for (int a = 0; a < 2; ++a)
#pragma unroll
        for (int b = 0; b < 2; ++b)
#pragma unroll
            for (int m = 0; m < 4; ++m)
#pragma unroll
                for (int n = 0; n < 2; ++n) acc[a][b][m][n] = (f32x4){0.f, 0.f, 0.f, 0.f};
    bf16x8 At[4][2], B0[2][2], B1[2][2];
    const char* cA = (const char*)g.A + (size_t)cur.pm * tstep; const char* cB = (const char*)g.Bt + (size_t)cur.pn * tstep;
    S.a_ready(cur);
    if constexpr (SP2) {
        PG8_STAGE(PG8_SB(0, 0), cB, voffB); PG8_STAGE(PG8_SB(0, 1), cB + hstep, voffB); PG8_STAGE(PG8_SA(0, 0), cA, voffA); PG8_STAGE(PG8_SA(0, 1), cA + hstep, voffA);
        if (wr == 1) PG8_BAR;
        PG8_WAIT_V(2); PG8_BAR;
        PG8_STAGE(PG8_SB(1, 0), cB + kstep, voffB); PG8_STAGE(PG8_SA(1, 0), cA + kstep, voffA); PG8_STAGE(PG8_SB(1, 1), cB + hstep + kstep, voffB);
        PG8_WAIT_V(6); PG8_BAR;
    } else {
        PG8_STAGE(PG8_SB(0, 0), cB, voffB); PG8_STAGE(PG8_SA(0, 0), cA, voffA); PG8_STAGE(PG8_SB(0, 1), cB + hstep, voffB); PG8_STAGE(PG8_SA(0, 1), cA + hstep, voffA);
        if (wr == 1) PG8_BAR;
        PG8_WAIT_V(4); PG8_BAR;
        PG8_STAGE(PG8_SB(1, 0), cB + kstep, voffB); PG8_STAGE(PG8_SA(1, 0), cA + kstep, voffA); PG8_STAGE(PG8_SB(1, 1), cB + hstep + kstep, voffB);
        PG8_WAIT_V(6); PG8_BAR;
    }
    for (;;) {
        const bool has_next = S.next(ui + 1, nxt);
        const char* nA = has_next ? (const char*)g.A + (size_t)nxt.pm * tstep : cA; const char* nB = has_next ? (const char*)g.Bt + (size_t)nxt.pn * tstep : cB;
#pragma nounroll
        for (int t = 0; t < nt; t += 2) {
            const bool last = (t == nt - 2);
            const char* a1 = cA + (size_t)(t + 1) * kstep;
            const char* a2 = last ? nA : cA + (size_t)(t + 2) * kstep; const char* b2 = last ? nB : cB + (size_t)(t + 2) * kstep;
            const char* a3 = a2 + kstep; const char* b3 = b2 + kstep;
            if (last && has_next) S.a_ready(nxt);
            if constexpr (SP2) {
            PG8_LDB(B0, 0, 0); PG8_LDB(B1, 0, 1); PG8_SCHED; PG8_LDA(At, 0, 0); PG8_STAGE(PG8_SA(1, 1), a1 + hstep, voffA);
            PG8_WAIT_V(8); PG8_WAIT_L(0); PG8_BAR; PG8_MMA(0, 0, At, B0); PG8_MMA(0, 1, At, B1); PG8_BAR; PG8_SCHED;
            PG8_LDA(At, 0, 1); PG8_STAGE(PG8_SB(0, 0), b2, voffB); PG8_STAGE(PG8_SB(0, 1), b2 + hstep, voffB); PG8_STAGE(PG8_SA(0, 0), a2, voffA);
            PG8_WAIT_V(8); PG8_WAIT_L(0); PG8_BAR; PG8_MMA(1, 0, At, B0); PG8_MMA(1, 1, At, B1); PG8_BAR; PG8_SCHED;
            PG8_LDB(B0, 1, 0); PG8_LDB(B1, 1, 1); PG8_SCHED; PG8_LDA(At, 1, 0); PG8_STAGE(PG8_SA(0, 1), a2 + hstep, voffA);
            PG8_WAIT_V(8); PG8_WAIT_L(0); PG8_BAR; PG8_MMA(0, 0, At, B0); PG8_MMA(0, 1, At, B1); PG8_BAR; PG8_SCHED;
            PG8_LDA(At, 1, 1); PG8_STAGE(PG8_SB(1, 0), b3, voffB); PG8_STAGE(PG8_SB(1, 1), b3 + hstep, voffB); PG8_STAGE(PG8_SA(1, 0), a3, voffA);
            PG8_WAIT_V(8); PG8_WAIT_L(0); PG8_BAR; PG8_MMA(1, 0, At, B0); PG8_MMA(1, 1, At, B1); PG8_BAR; PG8_SCHED;
            } else {
            PG8_LDB(B0, 0, 0); PG8_SCHED; PG8_LDA(At, 0, 0); PG8_STAGE(PG8_SA(1, 1), a1 + hstep, voffA);
            PG8_WAIT_L(8); PG8_BAR; PG8_WAIT_L(0); PG8_MMA(0, 0, At, B0); PG8_BAR; PG8_SCHED;
            PG8_LDB(B1, 0, 1); PG8_STAGE(PG8_SB(0, 0), b2, voffB);
            PG8_BAR; PG8_WAIT_L(0); PG8_MMA(0, 1, At, B1); PG8_BAR;
            PG8_LDA(At, 0, 1); PG8_STAGE(PG8_SA(0, 0), a2, voffA);
            PG8_BAR; PG8_WAIT_L(0); PG8_MMA(1, 0, At, B0); PG8_BAR; PG8_SCHED;
            PG8_STAGE(PG8_SB(0, 1), b2 + hstep, voffB);
            PG8_WAIT_V(6); PG8_BAR; PG8_MMA(1, 1, At, B1); PG8_BAR;
            PG8_LDB(B0, 1, 0); PG8_SCHED; PG8_LDA(At, 1, 0); PG8_STAGE(PG8_SA(0, 1), a2 + hstep, voffA);
            PG8_WAIT_L(8); PG8_BAR; PG8_WAIT_L(0); PG8_MMA(0, 0, At, B0); PG8_BAR; PG8_SCHED;
            PG8_LDB(B1, 1, 1); PG8_STAGE(PG8_SB(1, 0), b3, voffB);
            PG8_BAR; PG8_WAIT_L(0); PG8_MMA(0, 1, At, B1); PG8_BAR;
            PG8_LDA(At, 1, 1); PG8_STAGE(PG8_SA(1, 0), a3, voffA);
            PG8_BAR; PG8_WAIT_L(0); PG8_MMA(1, 0, At, B0); PG8_BAR; PG8_SCHED;
            PG8_STAGE(PG8_SB(1, 1), b3 + hstep, voffB);
            PG8_WAIT_V(6); PG8_BAR; PG8_MMA(1, 1, At, B1); PG8_BAR;
            }
        }
        if constexpr (ALIGN_EPI) { if (wr == 0) PG8_BAR; }
        if constexpr (!Epi::AFTER_DRAIN) { E(acc, cur, wr, wc, fr, fq); S.done(cur); }
        if (!has_next) break;
#pragma unroll
        for (int a = 0; a < 2; ++a)
#pragma unroll
            for (int b = 0; b < 2; ++b)
#pragma unroll
                for (int m = 0; m < 4; ++m)
#pragma unroll
                    for (int n = 0; n < 2; ++n) acc[a][b][m][n] = (f32x4){0.f, 0.f, 0.f, 0.f};
        cur = nxt; cA = nA; cB = nB; ++ui;
        if constexpr (ALIGN_EPI) { if (wr == 1) PG8_BAR; }
    }
    PG8_WAIT_V(0);
    if constexpr (!ALIGN_EPI) { if (wr == 0) PG8_BAR; }
    PG8_BAR;
    if constexpr (Epi::AFTER_DRAIN) { E.fused(acc, cur, wr, wc, fr, fq, lds, wid, lane); S.done(cur); }
#undef PG8_SA
#undef PG8_SB
#undef PG8_STAGE
#undef PG8_LDA
#undef PG8_LDB
#undef PG8_MMA
#undef PG8_CAT8
#undef PG8_WAIT_V
#undef PG8_WAIT_L
#undef PG8_BAR
#undef PG8_SCHED
}
}

#define PG8_SP2 true
#define PG8_ALIGN true

constexpr int NWAVES = 8;
constexpr int M = 16384, D = 2048, SEQ = 4096, NB = 4;
constexpr int NIN = 7168;
constexpr int IN_COLS = 7184;
constexpr int FFN = 5632, EFF = 7168, NEXP = 8, PLE = 256;
constexpr int CAP = 2 * M + NEXP * 256;
constexpr float EPS = 1e-6f;

#ifndef MK_N_LAUNCHES
#define MK_N_LAUNCHES 1
#endif
constexpr int N_PHASES = 26;
constexpr int N_LAUNCHES = MK_N_LAUNCHES;

constexpr size_t MiB = 1u << 20;
constexpr size_t WS_CTL = 0, CTL_ZERO_BYTES = 1 * MiB;
constexpr size_t WS_SMALL = 1 * MiB;
constexpr size_t SM_LB = 0, SM_L1M = 8192, SM_HIST = 16384, SM_PSTART = 24576, SM_TOPW = 65536, SM_RANKE = 196608, SM_TOKSLOT = 327680, SM_SLOTW = 458752, SM_WGLR = 655360;
constexpr size_t WS_WIN = 2 * MiB, WS_WOUT = 62 * MiB, WS_WPG = 78 * MiB, WS_WPP = 94 * MiB, WS_WGU = 96 * MiB, WS_WD = 140 * MiB, WS_MGU = 162 * MiB, WS_MD = 610 * MiB;
constexpr size_t WS_HN = 834 * MiB, WS_PB = 898 * MiB, WS_PP = 914 * MiB, WS_A = 978 * MiB, WS_XS = 1490 * MiB, WS_MIXV = 1626 * MiB, WS_PART = 1699 * MiB, WS_GLR = 1705 * MiB, WS_END = 1706 * MiB;
constexpr size_t A_QH = 0, A_KH = 32 * MiB, A_VH = 64 * MiB, A_GH = 96 * MiB, A_GATE = 160 * MiB, A_QG = 224 * MiB, A_KG = 240 * MiB, A_VG = 256 * MiB, A_GG = 288 * MiB, A_ORAW = 320 * MiB, A_O = 448 * MiB;
static_assert((size_t)CAP * EFF * 2 <= 512 * MiB && (size_t)CAP * D * 2 <= 136 * MiB && SM_SLOTW + (size_t)CAP * 4 <= MiB, "ws map");
constexpr int CW_TMO = 0, CW_CODE = 1, CW_BAR = 4096;

constexpr int RING_OFF = 0, RING_BYTES = 131072;
constexpr int LDS_BYTES = 163840;
constexpr int LDSCTL_OFF = LDS_BYTES - 512, MISC_OFF = LDSCTL_OFF + 320;

#define GAS __attribute__((address_space(1)))
#define LAS __attribute__((address_space(3)))
typedef unsigned short bf16;
typedef unsigned v4u __attribute__((ext_vector_type(4)));
typedef unsigned v2u __attribute__((ext_vector_type(2)));
typedef float f32x4 __attribute__((ext_vector_type(4)));
typedef short bf16x8 __attribute__((ext_vector_type(8)));
typedef GAS unsigned gu32;
#define RLX_AGENT __ATOMIC_RELAXED, __HIP_MEMORY_SCOPE_AGENT
#define LDS_WAIT() asm volatile("s_waitcnt lgkmcnt(0)" ::: "memory")
__device__ __forceinline__ unsigned f2bf(float f) { unsigned u = __builtin_bit_cast(unsigned, f); return (u + 0x7fffu + ((u >> 16) & 1u)) >> 16; }
__device__ __forceinline__ unsigned pk2(float lo, float hi) { return pg8::cvt_pk_bf16(lo, hi); }
__device__ __forceinline__ float bflo(unsigned u) { return __uint_as_float(u << 16); }
__device__ __forceinline__ float bfhi(unsigned u) { return __uint_as_float(u & 0xffff0000u); }
__device__ __forceinline__ float fex(float x) { return __builtin_amdgcn_exp2f(x * 1.44269504089f); }

struct Args { const float* in[22]; float* out; unsigned char* ws; int ph_lo, ph_hi, li, pad; };
typedef const __attribute__((address_space(4))) Args* KArgs;
__device__ __forceinline__ KArgs kargs() { KArgs p = (KArgs)__builtin_amdgcn_kernarg_segment_ptr(); asm volatile("" : "+s"(p)); return p; }
#define XB_TMO      128
#define XB_XCNT(j)  (256  + 64 * (j))
#define XB_XSUB(j)  (1280 + 64 * (j))
#define XB_XGEN(j)  (2304 + 64 * (j))
#define XB_TOP      3328
#define XB_TOPGEN   3392
#define XCD_BAR_WORDS 3456
#define XB_SPIN_CAP (1u << 18)

__device__ __forceinline__ unsigned xb_ld(unsigned* p)              { return __hip_atomic_load(p, __ATOMIC_RELAXED, __HIP_MEMORY_SCOPE_AGENT); }
__device__ __forceinline__ unsigned xb_add(unsigned* p, unsigned v) { return __hip_atomic_fetch_add(p, v, __ATOMIC_RELAXED, __HIP_MEMORY_SCOPE_AGENT); }
__device__ __forceinline__ unsigned xb_xcc_id() { return (unsigned)__builtin_amdgcn_s_getreg((3 << 11) | 20) & 0xFu; }
#define XB_SPIN(cond, bar) do { unsigned _sp = 0; while (cond) { __builtin_amdgcn_s_sleep(1); \
    if ((++_sp & 255u) == 0u) { if (xb_ld(&(bar)[XB_TMO])) break; if (_sp > XB_SPIN_CAP) { atomicAdd(&(bar)[XB_TMO], 1u); break; } } } } while (0)

struct XcdBarrier {
    unsigned* bar; unsigned x;
    volatile LAS unsigned* st;
};

__device__ __forceinline__ XcdBarrier xcd_barrier_post(unsigned* bar, volatile LAS unsigned* st) {
    XcdBarrier b; b.bar = bar; b.x = xb_xcc_id(); b.st = st;
    if (threadIdx.x == 0) (void)xb_add(&bar[XB_XCNT(b.x)], 1u);
    return b;
}
__device__ __forceinline__ void xcd_barrier_complete(unsigned* bar, unsigned x, unsigned& nloc, unsigned& nx) {
    const unsigned G = gridDim.x * gridDim.y * gridDim.z;
    unsigned sum, cnt, mine, sp = 0u;
    for (;;) {
        sum = 0u; cnt = 0u; mine = 0u;
#pragma unroll
        for (unsigned j = 0; j < 16; ++j) { const unsigned c = xb_ld(&bar[XB_XCNT(j)]); sum += c; cnt += (c > 0u) ? 1u : 0u; mine = (j == x) ? c : mine; }
        if (sum == G) break;
        __builtin_amdgcn_s_sleep(1);
        if ((++sp & 255u) == 0u) { if (xb_ld(&bar[XB_TMO])) break; if (sp > XB_SPIN_CAP) { atomicAdd(&bar[XB_TMO], 1u); break; } }
    }
    nloc = mine > 0u ? mine : 1u; nx = cnt > 0u ? cnt : 1u;
}

__device__ __forceinline__ void xcd_barrier(const XcdBarrier& b) {
    asm volatile("s_waitcnt vmcnt(0)" ::: "memory");
    __syncthreads();
    if (threadIdx.x == 0) {
        unsigned* bar = b.bar;
        __builtin_amdgcn_s_waitcnt(0);
        unsigned nloc = b.st[0], nx = b.st[1];
        if (nloc == 0u) { xcd_barrier_complete(bar, b.x, nloc, nx); b.st[0] = nloc; b.st[1] = nx; }
        const unsigned old = xb_add(&bar[XB_XSUB(b.x)], 1u);
        const unsigned gen = old / nloc;
        if (old + 1u == (gen + 1u) * nloc) {
            __builtin_amdgcn_fence(__ATOMIC_RELEASE, "agent");
            asm volatile("s_waitcnt vmcnt(0)" ::: "memory");
            const unsigned og = xb_add(&bar[XB_TOP], 1u);
            const unsigned tg = og / nx;
            if (og + 1u == (tg + 1u) * nx) xb_add(&bar[XB_TOPGEN], 1u);
            else XB_SPIN(xb_ld(&bar[XB_TOPGEN]) == tg, bar);
            __builtin_amdgcn_fence(__ATOMIC_ACQUIRE, "agent");
            xb_add(&bar[XB_XGEN(b.x)], 1u);
            asm volatile("s_waitcnt vmcnt(0)" ::: "memory");
        } else {
            XB_SPIN(xb_ld(&bar[XB_XGEN(b.x)]) == gen, bar);
            __builtin_amdgcn_fence(__ATOMIC_ACQUIRE, "agent");
            asm volatile("s_waitcnt vmcnt(0)" ::: "memory");
        }
    }
    __syncthreads();
}


struct Frame {
    LAS unsigned char* lds;
    volatile LAS unsigned* MISC;
    gu32* ctl;
    int tid, lane, wave, vcu, G;
    unsigned char* ws;
};
__device__ __forceinline__ float wave_sum(float v) {
#pragma unroll
    for (int o = 1; o < 64; o <<= 1) v += __shfl_xor(v, o);
    return v;
}
__device__ __forceinline__ void p0_transpose_item(const float* W, int ldw, int col0, int K, int ncols, bf16* WT, int mode, int rowoff, LAS float* scr, int item, int lane, const float* kgain = nullptr) {
    const int nblk = ncols / 32, kb = item / nblk, nb = item % nblk, k0 = 64 * kb, n0 = 32 * nb;
    const float* src = W + (size_t)k0 * ldw + col0 + n0 + (lane & 31) + (size_t)(lane >> 5) * ldw;
#pragma unroll 16
    for (int i = 0; i < 32; ++i) { const int kk = 2 * i + (lane >> 5); scr[kk * 33 + (lane & 31)] = src[(size_t)(2 * i) * ldw]; }
    LDS_WAIT(); asm volatile("" ::: "memory");
    const int c = lane & 7;
    const int rbase = mode == 0 ? rowoff + n0 : rowoff + (n0 >> 7) * 256 + (n0 & 127) + (mode == 2 ? 128 : 0);
    f32x4 ga = {1.f, 1.f, 1.f, 1.f}, gb = {1.f, 1.f, 1.f, 1.f};
    if (kgain) { ga = *(const GAS f32x4*)(kgain + k0 + 8 * c); gb = *(const GAS f32x4*)(kgain + k0 + 8 * c + 4); }
#pragma unroll
    for (int j = 0; j < 4; ++j) { const int n = (lane >> 3) + 8 * j; const LAS float* s = scr + (8 * c) * 33 + n;
        v4u o; o.x = pk2(s[0 * 33] * ga.x, s[1 * 33] * ga.y); o.y = pk2(s[2 * 33] * ga.z, s[3 * 33] * ga.w); o.z = pk2(s[4 * 33] * gb.x, s[5 * 33] * gb.y); o.w = pk2(s[6 * 33] * gb.z, s[7 * 33] * gb.w);
        *(GAS v4u*)(WT + (size_t)(rbase + n) * K + k0 + 8 * c) = o; }
    LDS_WAIT(); asm volatile("" ::: "memory");
}
__device__ __forceinline__ void p0_transpose_item8(const float* W, int ldw, int K, int ncols, unsigned char* WT, int mode, float sc, LAS float* scr, int item, int lane) {
    const int nblk = ncols / 32, kb = item / nblk, nb = item % nblk, k0 = 64 * kb, n0 = 32 * nb;
    const float* src = W + (size_t)k0 * ldw + n0 + (lane & 31) + (size_t)(lane >> 5) * ldw;
#pragma unroll 16
    for (int i = 0; i < 32; ++i) { const int kk = 2 * i + (lane >> 5); scr[kk * 33 + (lane & 31)] = src[(size_t)(2 * i) * ldw]; }
    LDS_WAIT(); asm volatile("" ::: "memory");
    const int c = lane & 3;
    const int rbase = mode == 0 ? n0 : (n0 >> 7) * 256 + (n0 & 127) + (mode == 2 ? 128 : 0);
#pragma unroll
    for (int j = 0; j < 2; ++j) { const int n = (lane >> 2) + 16 * j; const LAS float* s = scr + (16 * c) * 33 + n;
        v4u o; o.x = pg8::pk4_fp8(s[0 * 33] * sc, s[1 * 33] * sc, s[2 * 33] * sc, s[3 * 33] * sc); o.y = pg8::pk4_fp8(s[4 * 33] * sc, s[5 * 33] * sc, s[6 * 33] * sc, s[7 * 33] * sc);
        o.z = pg8::pk4_fp8(s[8 * 33] * sc, s[9 * 33] * sc, s[10 * 33] * sc, s[11 * 33] * sc); o.w = pg8::pk4_fp8(s[12 * 33] * sc, s[13 * 33] * sc, s[14 * 33] * sc, s[15 * 33] * sc);
        *(GAS v4u*)(WT + (size_t)(rbase + n) * K + k0 + 16 * c) = o; }
    LDS_WAIT(); asm volatile("" ::: "memory");
}
__device__ __forceinline__ void p0_prologue(Frame& F, KArgs ka) {
    LAS float* scr = (LAS float*)(F.lds + RING_OFF + F.wave * 16384);
    const int gw = F.vcu * NWAVES + F.wave, NGW = F.G * NWAVES;
    unsigned char* ws = F.ws;
    if (F.vcu == 0) { float* LB = (float*)(ws + WS_SMALL + SM_LB); float* L1M = (float*)(ws + WS_SMALL + SM_L1M); const float* lg_ = ka->in[4];
        for (int c = F.tid; c < 1024; c += NWAVES * 64) { const float l0 = lg_[c], l1 = lg_[1024 + c]; const float s1 = 1.0f / (1.0f + __expf(l0 - l1));
            LB[c] = 0.f; L1M[c] = 0.f; LB[1024 + c] = s1; L1M[1024 + c] = __logf(1.0f - s1); } }
    { const GAS f32x4* src = (const GAS f32x4*)ka->in[1]; GAS v2u* dst = (GAS v2u*)(ws + WS_PB); const size_t n4 = (size_t)2 * M * PLE / 4;
        for (size_t i = (size_t)gw * 64 + F.lane; i < n4; i += (size_t)NGW * 64) { const f32x4 v = src[i]; v2u o; o.x = pk2(v.x, v.y); o.y = pk2(v.z, v.w); dst[i] = o; } }
    { bf16* WG = (bf16*)(ws + WS_SMALL + SM_WGLR);
        for (int i = gw * 64 + F.lane; i < 2 * D; i += NGW * 64) { const int l = i / D, k = i % D; const float gn = l == 1 ? ka->in[2][D + k] : 1.0f;
            const float* wi = ka->in[3] + (size_t)l * D * IN_COLS + (size_t)k * IN_COLS + 6144;
#pragma unroll
            for (int r = 0; r < 16; ++r) WG[(size_t)(l * 16 + r) * D + k] = (bf16)(pk2(wi[r] * gn, 0.f) & 0xffffu); } }
    constexpr int I_A = 32 * 192, I_B = 32 * 32, I_C = 32 * 64, I_E = 4 * 64, I_F = 32 * 176, I_G = 88 * 64, I_H = 32 * 224, I_I = 112 * 64;
    constexpr int NITEMS = 2 * (I_A + I_B + 2 * I_C + I_E) + 2 * I_F + I_G + 8 * (2 * I_H + I_I);
    struct Job { const float* src; const float* kg; unsigned char* WT; int ldw, K, rbase, k0; float sc; bool f8; };
    auto decode = [&](int it) -> Job {
        int r = it; const float* W; int ldw, col0 = 0, K, ncols, mode = 0, rowoff = 0, item; const float* kg = nullptr; unsigned char* WT; bool f8 = false; float sc = 1.0f;
        if (r < 2 * I_A) { const int l = r / I_A; W = ka->in[3] + (size_t)l * D * IN_COLS; ldw = IN_COLS; K = D; ncols = 6144; WT = ws + WS_WIN + (size_t)l * NIN * D * 2; kg = l == 1 ? ka->in[2] + D : nullptr; item = r % I_A; }
        else if ((r -= 2 * I_A) < 2 * I_B) { const int l = r / I_B; W = ka->in[3] + (size_t)l * D * IN_COLS; ldw = IN_COLS; col0 = 6160; K = D; ncols = 1024; rowoff = 6144; WT = ws + WS_WIN + (size_t)l * NIN * D * 2; kg = l == 1 ? ka->in[2] + D : nullptr; item = r % I_B; }
        else if ((r -= 2 * I_B) < 2 * I_C) { const int l = r / I_C; W = ka->in[9] + (size_t)l * D * D; ldw = D; K = D; ncols = D; WT = ws + WS_WOUT + (size_t)l * D * D * 2; item = r % I_C; }
        else if ((r -= 2 * I_C) < I_C) { W = ka->in[19]; ldw = D; K = D; ncols = D; WT = ws + WS_WPG; kg = ka->in[18]; item = r; }
        else if ((r -= I_C) < I_C) { W = ka->in[19] + (size_t)D * D; ldw = D; K = D; ncols = D; WT = ws + WS_WPG + 8 * MiB; f8 = true; sc = pg8::F8_SWU; item = r; }
        else if ((r -= I_C) < 2 * I_E) { const int l = r / I_E; W = ka->in[20] + (size_t)l * PLE * D; ldw = D; K = PLE; ncols = D; WT = ws + WS_WPP + (size_t)l * D * PLE * 2; item = r % I_E; }
        else if ((r -= 2 * I_E) < I_F) { W = ka->in[11]; ldw = FFN; K = D; ncols = FFN; WT = ws + WS_WGU; mode = 1; kg = ka->in[10]; item = r; }
        else if ((r -= I_F) < I_F) { W = ka->in[12]; ldw = FFN; K = D; ncols = FFN; WT = ws + WS_WGU; mode = 2; kg = ka->in[10]; item = r; }
        else if ((r -= I_F) < I_G) { W = ka->in[13]; ldw = D; K = FFN; ncols = D; WT = ws + WS_WD; item = r; }
        else if ((r -= I_G) < 8 * I_H) { const int e = r / I_H; W = ka->in[15] + (size_t)e * D * EFF; ldw = EFF; K = D; ncols = EFF; WT = ws + WS_MGU + (size_t)e * 2 * EFF * D; mode = 1; f8 = true; sc = pg8::F8_SWU; item = r % I_H; }
        else if ((r -= 8 * I_H) < 8 * I_H) { const int e = r / I_H; W = ka->in[16] + (size_t)e * D * EFF; ldw = EFF; K = D; ncols = EFF; WT = ws + WS_MGU + (size_t)e * 2 * EFF * D; mode = 2; f8 = true; sc = pg8::F8_SWU; item = r % I_H; }
        else { r -= 8 * I_H; const int e = r / I_I; W = ka->in[17] + (size_t)e * EFF * D; ldw = D; K = EFF; ncols = D; WT = ws + WS_MD + (size_t)e * D * EFF; f8 = true; sc = pg8::F8_SWD; item = r % I_I; }
        const int nblk = ncols / 32, kb = item / nblk, nb = item % nblk, k0 = 64 * kb, n0 = 32 * nb;
        Job j; j.src = W + (size_t)(k0 + (F.lane >> 5)) * ldw + col0 + n0 + (F.lane & 31); j.kg = kg; j.WT = WT; j.ldw = ldw; j.K = K; j.k0 = k0; j.sc = sc; j.f8 = f8;
        j.rbase = mode == 0 ? rowoff + n0 : rowoff + (n0 >> 7) * 256 + (n0 & 127) + (mode == 2 ? 128 : 0);
        return j; };
    float t[32], tn[32];
    int it = gw;
    if (it < NITEMS) {
        Job cur = decode(it);
#pragma unroll
        for (int i = 0; i < 32; ++i) t[i] = cur.src[(size_t)(2 * i) * cur.ldw];
        for (;;) {
            const int nx = it + NGW; const bool more = nx < NITEMS; Job nxt = cur;
            if (more) { nxt = decode(nx);
#pragma unroll
                for (int i = 0; i < 32; ++i) tn[i] = nxt.src[(size_t)(2 * i) * nxt.ldw]; }
#pragma unroll
            for (int i = 0; i < 32; ++i) scr[(2 * i + (F.lane >> 5)) * 33 + (F.lane & 31)] = t[i];
            LDS_WAIT(); asm volatile("" ::: "memory");
            if (cur.f8) { const int c = F.lane & 3; const float sc = cur.sc;
#pragma unroll
                for (int j = 0; j < 2; ++j) { const int n = (F.lane >> 2) + 16 * j; const LAS float* s = scr + (16 * c) * 33 + n;
                    v4u o; o.x = pg8::pk4_fp8(s[0 * 33] * sc, s[1 * 33] * sc, s[2 * 33] * sc, s[3 * 33] * sc); o.y = pg8::pk4_fp8(s[4 * 33] * sc, s[5 * 33] * sc, s[6 * 33] * sc, s[7 * 33] * sc);
                    o.z = pg8::pk4_fp8(s[8 * 33] * sc, s[9 * 33] * sc, s[10 * 33] * sc, s[11 * 33] * sc); o.w = pg8::pk4_fp8(s[12 * 33] * sc, s[13 * 33] * sc, s[14 * 33] * sc, s[15 * 33] * sc);
                    *(GAS v4u*)(cur.WT + (size_t)(cur.rbase + n) * cur.K + cur.k0 + 16 * c) = o; }
            } else { const int c = F.lane & 7;
                f32x4 ga = {1.f, 1.f, 1.f, 1.f}, gb = {1.f, 1.f, 1.f, 1.f};
                if (cur.kg) { ga = *(const GAS f32x4*)(cur.kg + cur.k0 + 8 * c); gb = *(const GAS f32x4*)(cur.kg + cur.k0 + 8 * c + 4); }
#pragma unroll
                for (int j = 0; j < 4; ++j) { const int n = (F.lane >> 3) + 8 * j; const LAS float* s = scr + (8 * c) * 33 + n;
                    v4u o; o.x = pk2(s[0 * 33] * ga.x, s[1 * 33] * ga.y); o.y = pk2(s[2 * 33] * ga.z, s[3 * 33] * ga.w); o.z = pk2(s[4 * 33] * gb.x, s[5 * 33] * gb.y); o.w = pk2(s[6 * 33] * gb.z, s[7 * 33] * gb.w);
                    *(GAS v4u*)((bf16*)cur.WT + (size_t)(cur.rbase + n) * cur.K + cur.k0 + 8 * c) = o; } }
            LDS_WAIT(); asm volatile("" ::: "memory");
            if (!more) break;
            cur = nxt; it = nx;
#pragma unroll
            for (int i = 0; i < 32; ++i) t[i] = tn[i];
        }
    }
}

constexpr int RSTD_OFF = RING_BYTES;
__device__ __forceinline__ int prep_rstd(Frame& F, const float* part) {
    const int rbase = ((int)blockIdx.x & 7) * 2048;
    LAS float* rt = (LAS float*)(F.lds + RSTD_OFF);
    for (int r = F.tid; r < 2048; r += NWAVES * 64) { const GAS f32x4* p = (const GAS f32x4*)(part + (size_t)(rbase + r) * 32);
        float s = 0.f;
#pragma unroll
        for (int j = 0; j < 8; ++j) { const f32x4 a = p[j]; s += (a.x + a.y) + (a.z + a.w); }
        rt[r] = 1.0f / sqrtf(s * (1.0f / D) + EPS); }
    __syncthreads();
    return rbase;
}
constexpr int GLR_PITCH = 2 * D + 16;
__device__ __forceinline__ void glr_phase(Frame& F, const bf16* HNA, const bf16* WG, bool use_rstd, float* GLR) {
    LAS unsigned char* T = F.lds + RING_OFF;
    for (int i = F.tid; i < 16 * 256; i += NWAVES * 64) { const int r = i >> 8, c16 = i & 255; *(LAS v4u*)(T + r * GLR_PITCH + 16 * c16) = *(const GAS v4u*)(WG + (size_t)r * D + 8 * c16); }
    __syncthreads();
    if (F.wave < 4) {
        const int lane = F.lane, n = lane & 15, q = lane >> 4;
        const int rbase = ((int)blockIdx.x & 7) * 2048, rl0 = ((int)blockIdx.x >> 3) * 64 + F.wave * 16;
        const bf16* arow = HNA + (size_t)(rbase + rl0 + n) * D + 8 * q;
        f32x4 acc = {0.f, 0.f, 0.f, 0.f};
#pragma nounroll
        for (int sb = 0; sb < 4; ++sb) { bf16x8 a[16];
#pragma unroll
            for (int s = 0; s < 16; ++s) a[s] = *(const GAS bf16x8*)(arow + 32 * (16 * sb + s));
#pragma unroll
            for (int s = 0; s < 16; ++s) { const bf16x8 b = *(const LAS bf16x8*)(T + n * GLR_PITCH + (32 * (16 * sb + s) + 8 * q) * 2);
                acc = __builtin_amdgcn_mfma_f32_16x16x32_bf16(a[s], b, acc, 0, 0, 0); } }
        const LAS float* rt = (const LAS float*)(F.lds + RSTD_OFF);
#pragma unroll
        for (int j = 0; j < 4; ++j) { const int rl = rl0 + 4 * q + j; const float v = use_rstd ? acc[j] * rt[rl] : acc[j]; GLR[(size_t)(rbase + rl) * 16 + n] = v; }
    }
    __syncthreads();
}
__device__ __forceinline__ void load_row(const float* row, int lane, f32x4 (&v)[8]) {
    const GAS f32x4* xr = (const GAS f32x4*)row + lane;
#pragma unroll
    for (int j = 0; j < 8; ++j) v[j] = xr[64 * j];
}
__device__ __forceinline__ float row_rstd(const f32x4 (&v)[8]) {
    float s = 0.f;
#pragma unroll
    for (int j = 0; j < 8; ++j) s += (v[j].x * v[j].x + v[j].y * v[j].y) + (v[j].z * v[j].z + v[j].w * v[j].w);
    return 1.0f / sqrtf(wave_sum(s) * (1.0f / D) + EPS);
}
__device__ __forceinline__ void norm_store_bf16(f32x4 (&v)[8], float rstd, const float* w, bf16* orow, int lane) {
    const GAS f32x4* wr = (const GAS f32x4*)w + lane; GAS v2u* o8 = (GAS v2u*)orow + lane;
#pragma unroll
    for (int j = 0; j < 8; ++j) { v[j] = v[j] * rstd * wr[64 * j]; v2u o; o.x = pk2(v[j].x, v[j].y); o.y = pk2(v[j].z, v[j].w); o8[64 * j] = o; }
}
__device__ __forceinline__ void norm_store_fp8(f32x4 (&v)[8], float rstd, const float* w, unsigned char* orow, int lane) {
    const GAS f32x4* wr = (const GAS f32x4*)w + lane; GAS unsigned* o4 = (GAS unsigned*)orow + lane;
#pragma unroll
    for (int j = 0; j < 8; ++j) { v[j] = v[j] * rstd * wr[64 * j]; o4[64 * j] = pg8::pk4_fp8(v[j].x * pg8::F8_SA, v[j].y * pg8::F8_SA, v[j].z * pg8::F8_SA, v[j].w * pg8::F8_SA); }
}
template <bool F8OUT> __device__ __forceinline__ void norm_phase(Frame& F, const float* Hsrc, const float* w, bf16* HN) {
    const int gw = F.vcu * NWAVES + F.wave, NGW = F.G * NWAVES;
    for (int m = gw; m < M; m += NGW) { f32x4 v[8]; load_row(Hsrc + (size_t)m * D, F.lane, v); const float rstd = row_rstd(v);
        if (F8OUT) norm_store_fp8(v, rstd, w, (unsigned char*)HN + (size_t)m * D, F.lane); else norm_store_bf16(v, rstd, w, HN + (size_t)m * D, F.lane); }
}
__device__ __forceinline__ void final_norm_phase(Frame& F, float* Hio, const float* w) {
    const int gw = F.vcu * NWAVES + F.wave, NGW = F.G * NWAVES;
    for (int m = gw; m < M; m += NGW) { f32x4 v[8]; load_row(Hio + (size_t)m * D, F.lane, v); const float rstd = row_rstd(v);
        const GAS f32x4* wr = (const GAS f32x4*)w + F.lane; GAS f32x4* o = (GAS f32x4*)(Hio + (size_t)m * D) + F.lane;
#pragma unroll
        for (int j = 0; j < 8; ++j) o[64 * j] = v[j] * rstd * wr[64 * j]; }
}
__device__ __forceinline__ void postmix_phase(Frame& F, const bf16* ORAW, const bf16* GATE, const float* hw, const float* gw_, bf16* O) {
    const int gw = F.vcu * NWAVES + F.wave, NGW = F.G * NWAVES;
    for (int m = gw; m < M; m += NGW) { f32x4 v[8]; { const GAS v2u* orr = (const GAS v2u*)(ORAW + (size_t)m * D) + F.lane;
#pragma unroll
            for (int j = 0; j < 8; ++j) { const v2u x = orr[64 * j]; v[j] = (f32x4){bflo(x.x), bfhi(x.x), bflo(x.y), bfhi(x.y)}; } }
        const GAS v2u* gr = (const GAS v2u*)(GATE + (size_t)m * D) + F.lane; GAS v2u* o8 = (GAS v2u*)(O + (size_t)m * D) + F.lane;
#pragma unroll
        for (int j = 0; j < 8; ++j) { float s = (v[j].x * v[j].x + v[j].y * v[j].y) + (v[j].z * v[j].z + v[j].w * v[j].w);
#pragma unroll
            for (int o = 1; o < 32; o <<= 1) s += __shfl_xor(s, o);
            float rstd;
            if (j < 4) rstd = 1.0f / sqrtf(s * (1.0f / 128.0f) + EPS); else { s += __shfl_xor(s, 32); rstd = 1.0f / sqrtf(s * (1.0f / 256.0f) + EPS); }
            const f32x4 wv = j < 4 ? ((const GAS f32x4*)hw + F.lane)[64 * j] : ((const GAS f32x4*)gw_ + F.lane)[64 * (j - 4)];
            const v2u g = gr[64 * j]; const f32x4 y = v[j] * rstd * wv;
            v2u o; o.x = pk2(y.x * bflo(g.x), y.y * bfhi(g.x)); o.y = pk2(y.z * bflo(g.y), y.w * bfhi(g.y)); o8[64 * j] = o; } }
}
__device__ __forceinline__ void norm_router_phase(Frame& F, const float* Hsrc, const float* w, const float* RW, unsigned char* HN8) {
    LAS float* RWt = (LAS float*)(F.lds + RING_OFF);
    LAS int* ESEL = (LAS int*)(F.lds + RING_OFF + 65536);
    for (int i = F.tid; i < 8 * D; i += NWAVES * 64) { const int k = i >> 3, e = i & 7; RWt[e * D + k] = RW[i]; }
    __syncthreads();
    float2* TOPW = (float2*)(F.ws + WS_SMALL + SM_TOPW); int* RANKE = (int*)(F.ws + WS_SMALL + SM_RANKE); int* HIST = (int*)(F.ws + WS_SMALL + SM_HIST);
    for (int chunk = F.vcu; chunk < M / 64; chunk += F.G) {
        for (int i = 0; i < 8; ++i) { const int rl = F.wave * 8 + i, m = chunk * 64 + rl;
            f32x4 v[8]; load_row(Hsrc + (size_t)m * D, F.lane, v); const float rstd = row_rstd(v); norm_store_fp8(v, rstd, w, HN8 + (size_t)m * D, F.lane);
            float lgt[8];
#pragma unroll
            for (int e = 0; e < 8; ++e) { float p = 0.f;
#pragma unroll
                for (int j = 0; j < 8; ++j) { const f32x4 t = *(const LAS f32x4*)(RWt + e * D + 256 * j + 4 * F.lane); p += (v[j].x * t.x + v[j].y * t.y) + (v[j].z * t.z + v[j].w * t.w); }
                lgt[e] = wave_sum(p); }
            int e0 = 0; float l0 = lgt[0];
#pragma unroll
            for (int e = 1; e < 8; ++e) if (lgt[e] > l0) { l0 = lgt[e]; e0 = e; }
            int e1 = -1; float l1 = -3.0e38f;
#pragma unroll
            for (int e = 0; e < 8; ++e) if (e != e0 && lgt[e] > l1) { l1 = lgt[e]; e1 = e; }
            const float w0 = 1.0f / (1.0f + __expf(l1 - l0));
            if (F.lane == 0) { ESEL[rl] = e0 | (e1 << 8); TOPW[m] = make_float2(w0, 1.0f - w0); } }
        __syncthreads();
        if (F.tid < 128) { const int a = F.tid, tok = a >> 1, kk = a & 1; const int ev = ESEL[tok]; const int e = kk ? (ev >> 8) : (ev & 255); int rank = 0;
            for (int a2 = 0; a2 < a; ++a2) { const int ev2 = ESEL[a2 >> 1]; const int e2 = (a2 & 1) ? (ev2 >> 8) : (ev2 & 255); rank += (e2 == e) ? 1 : 0; }
            RANKE[(chunk * 64 + tok) * 2 + kk] = e | (rank << 8); }
        if (F.tid >= 128 && F.tid < 136) { const int e = F.tid - 128; int cnt = 0;
            for (int t = 0; t < 64; ++t) { const int ev = ESEL[t]; cnt += ((ev & 255) == e) + ((ev >> 8) == e); }
            HIST[chunk * 8 + e] = cnt; }
        __syncthreads();
    }
}
__device__ __forceinline__ void moe_scatter_phase(Frame& F, const unsigned char* HN8, unsigned char* XS) {
    LAS int* HS = (LAS int*)(F.lds + RING_OFF);
    LAS int* PT = (LAS int*)(F.lds + RING_OFF + 8192);
    LAS int* BASE = (LAS int*)(F.lds + RING_OFF + 8192 + 512);
    const int* HIST = (const int*)(F.ws + WS_SMALL + SM_HIST); const int* RANKE = (const int*)(F.ws + WS_SMALL + SM_RANKE); const float* TOPW = (const float*)(F.ws + WS_SMALL + SM_TOPW);
    int* TOKSLOT = (int*)(F.ws + WS_SMALL + SM_TOKSLOT); float* SLOTW = (float*)(F.ws + WS_SMALL + SM_SLOTW); int* PSTART = (int*)(F.ws + WS_SMALL + SM_PSTART);
    bool first = true;
    for (int chunk = F.vcu; chunk < M / 64; chunk += F.G) {
        if (F.tid < 256) { const GAS v4u* h = (const GAS v4u*)(HIST + F.tid * 8); *(LAS v4u*)(HS + F.tid * 8) = h[0]; *(LAS v4u*)(HS + F.tid * 8 + 4) = h[1]; }
        __syncthreads();
        if (F.tid < 64) { const int e = F.tid & 7, part = F.tid >> 3; int tot = 0, pre = 0;
            for (int cc = part * 32; cc < part * 32 + 32; ++cc) { const int h = HS[cc * 8 + e]; tot += h; pre += (cc < chunk) ? h : 0; }
            PT[F.tid] = tot; PT[64 + F.tid] = pre; }
        __syncthreads();
        if (F.tid == 0) { int ps = 0;
            for (int e = 0; e < 8; ++e) { int tot = 0, pre = 0; for (int p = 0; p < 8; ++p) { tot += PT[p * 8 + e]; pre += PT[64 + p * 8 + e]; }
                BASE[e] = ps + pre; BASE[8 + e] = ps; ps += (tot + 255) & ~255; }
            BASE[16] = ps; }
        __syncthreads();
        if (F.vcu == 0 && first && F.tid < 9) PSTART[F.tid] = BASE[8 + F.tid];
        first = false;
        for (int a = F.wave * 16; a < F.wave * 16 + 16; ++a) { const int tok = chunk * 64 + (a >> 1), kk = a & 1; const int re = RANKE[tok * 2 + kk]; const int slot = BASE[re & 255] + (re >> 8);
            const GAS v4u* src = (const GAS v4u*)(HN8 + (size_t)tok * D) + F.lane; GAS v4u* dst = (GAS v4u*)(XS + (size_t)slot * D) + F.lane;
#pragma unroll
            for (int j = 0; j < 2; ++j) dst[64 * j] = src[64 * j];
            if (F.lane == 0) { TOKSLOT[tok * 2 + kk] = slot; SLOTW[slot] = TOPW[tok * 2 + kk]; } }
        __syncthreads();
    }
}
__device__ __forceinline__ void combine_norm_phase(Frame& F, float* Hio, const bf16* YS, const float* w, bf16* HN) {
    const int gw = F.vcu * NWAVES + F.wave, NGW = F.G * NWAVES; const int* TOKSLOT = (const int*)(F.ws + WS_SMALL + SM_TOKSLOT);
    for (int m = gw; m < M; m += NGW) { f32x4 v[8]; load_row(Hio + (size_t)m * D, F.lane, v);
        const int s0 = TOKSLOT[2 * m], s1 = TOKSLOT[2 * m + 1];
        const GAS v2u* y0 = (const GAS v2u*)(YS + (size_t)s0 * D) + F.lane; const GAS v2u* y1 = (const GAS v2u*)(YS + (size_t)s1 * D) + F.lane; GAS f32x4* ho = (GAS f32x4*)(Hio + (size_t)m * D) + F.lane;
#pragma unroll
        for (int j = 0; j < 8; ++j) { const v2u a = y0[64 * j], b = y1[64 * j];
            v[j].x += bflo(a.x) + bflo(b.x); v[j].y += bfhi(a.x) + bfhi(b.x); v[j].z += bflo(a.y) + bflo(b.y); v[j].w += bfhi(a.y) + bfhi(b.y); ho[64 * j] = v[j]; }
        const float rstd = row_rstd(v); norm_store_fp8(v, rstd, w, (unsigned char*)HN + (size_t)m * D, F.lane); }
}
constexpr int MX_QP = 272, MX_TP = 144;
constexpr int IM_QT = 0, IM_KTT = 17408, IM_PM = 35840, IM_RV = 45056, IM_LV = 45568, IM_BYTES = 46080;
constexpr int NITEM_H = NB * 8 * (SEQ / 64), NITEM_G = NB * 4 * (SEQ / 64);
constexpr int VT_H = 128 * MX_TP, VT_G = 256 * MX_TP;
constexpr int PX_SEG = 0, PX_RV = 8192, PX_LV = 8704, PX_QT = 9216, PX_KT = 26624, PX_KTT = 44032, PX_PM = 62464, PX_VT = 71680, PX_END = 108544;
#define MX_BAR() do { asm volatile("s_waitcnt lgkmcnt(0)" ::: "memory"); __builtin_amdgcn_s_barrier(); asm volatile("" ::: "memory"); } while (0)

__device__ __forceinline__ void mixpre_phase(Frame& F, const float* W2, const float* GB) {
    LAS unsigned char* L = F.lds + RING_OFF;
    unsigned char* A = F.ws + WS_A;
    const int tid = F.tid, lane = F.lane, w = F.wave;
    const int cq = tid & 31, rs = tid >> 5;
    const int tv = tid >> 3, vq = tid & 7;
    const int n = lane & 15, q4 = lane >> 4;
    constexpr int PX_W2 = PX_END, PX_GB = PX_END + 16 * 512 * 4;   static_assert(PX_GB + 2048 <= LDSCTL_OFF, "mixpre LDS");
    for (int i = tid; i < 16 * 512 / 4; i += NWAVES * 64) *(LAS f32x4*)(L + PX_W2 + 16 * i) = *(const GAS f32x4*)(W2 + 4 * i);
    if (tid < 128) *(LAS f32x4*)(L + PX_GB + 16 * tid) = *(const GAS f32x4*)(GB + 4 * tid);
    const float* GLR = (const float*)(F.ws + WS_GLR);
    f32x4 g[4]; v2u qv[4], kv[4]; v4u vv[4]; f32x4 gl[4][4];
#define PX_LOAD(IT) do { const int it_ = (IT); const bool hg_ = it_ < NITEM_H; const int i2_ = hg_ ? it_ : it_ - NITEM_H; \
        const int b_ = hg_ ? (i2_ >> 9) : (i2_ >> 8), h_ = hg_ ? ((i2_ >> 6) & 7) : ((i2_ >> 6) & 3), c_ = i2_ & 63; \
        const size_t t0_ = (size_t)b_ * SEQ + (size_t)c_ * 64; const int wqk_ = hg_ ? 1024 : 512; \
        const bf16* Qp_ = (const bf16*)(A + (hg_ ? A_QH : A_QG)) + h_ * 128; const bf16* Kp_ = (const bf16*)(A + (hg_ ? A_KH : A_KG)) + h_ * 128; \
        const float* Gp_ = (const float*)(A + A_GH) + h_ * 128; const bf16* Vp_ = (const bf16*)(A + (hg_ ? A_VH : A_VG)) + h_ * (hg_ ? 128 : 256); \
        _Pragma("unroll") for (int r = 0; r < 4; ++r) { const size_t ro = (t0_ + 4 * rs + r) * wqk_ + 4 * cq; \
            qv[r] = *(const GAS v2u*)(Qp_ + ro); kv[r] = *(const GAS v2u*)(Kp_ + ro); \
            if (hg_) g[r] = *(const GAS f32x4*)(Gp_ + ro); \
            else { const GAS f32x4* gp_ = (const GAS f32x4*)(GLR + (t0_ + 4 * rs + r) * 16); gl[r][0] = gp_[0]; gl[r][1] = gp_[1]; gl[r][2] = gp_[2]; gl[r][3] = gp_[3]; } } \
        const GAS v4u* vp_ = (const GAS v4u*)(Vp_ + (t0_ + tv) * 1024 + (hg_ ? 16 : 32) * vq); \
        vv[0] = vp_[0]; vv[1] = vp_[1]; if (!hg_) { vv[2] = vp_[2]; vv[3] = vp_[3]; } else { vv[2] = vv[0]; vv[3] = vv[0]; } } while (0)
    if (F.vcu < NITEM_H + NITEM_G) PX_LOAD(F.vcu);
    for (int it = F.vcu; it < NITEM_H + NITEM_G; it += F.G) {
        const bool hg = it < NITEM_H; const int i2 = hg ? it : it - NITEM_H;
        unsigned char* imq = F.ws + WS_XS + (size_t)it * IM_BYTES;
        unsigned char* imv = F.ws + WS_MIXV + (hg ? (size_t)i2 * VT_H : (size_t)NITEM_H * VT_H + (size_t)i2 * VT_G);
        if (!hg) { const int hh = (i2 >> 6) & 3;
            f32x4 z[4]; const f32x4 bz = *(const LAS f32x4*)(L + PX_GB + 4 * (hh * 128 + 4 * cq));
#pragma unroll
            for (int r = 0; r < 4; ++r) z[r] = bz;
#pragma unroll
            for (int r16 = 0; r16 < 16; ++r16) { const f32x4 wv = *(const LAS f32x4*)(L + PX_W2 + 4 * (r16 * 512 + hh * 128 + 4 * cq));
#pragma unroll
                for (int r = 0; r < 4; ++r) z[r] += wv * gl[r][r16 >> 2][r16 & 3]; }
#pragma unroll
            for (int r = 0; r < 4; ++r) { g[r].x = pg8::logsig(z[r].x) * 0.0625f; g[r].y = pg8::logsig(z[r].y) * 0.0625f; g[r].z = pg8::logsig(z[r].z) * 0.0625f; g[r].w = pg8::logsig(z[r].w) * 0.0625f; } }
        f32x4 pre[4]; pre[0] = g[0]; pre[1] = pre[0] + g[1]; pre[2] = pre[1] + g[2]; pre[3] = pre[2] + g[3];
        *(LAS f32x4*)(L + PX_SEG + (rs * 128 + 4 * cq) * 4) = pre[3];
#pragma unroll
        for (int j = 0; j < 4; ++j) if (j < 2 || !hg) { const int c0 = (hg ? 16 : 32) * vq + 8 * j; const v4u x = vv[j];
            LAS unsigned short* vt = (LAS unsigned short*)(L + PX_VT + 2 * tv);
            vt[(c0 + 0) * (MX_TP / 2)] = (unsigned short)(x.x & 0xffffu); vt[(c0 + 1) * (MX_TP / 2)] = (unsigned short)(x.x >> 16); vt[(c0 + 2) * (MX_TP / 2)] = (unsigned short)(x.y & 0xffffu); vt[(c0 + 3) * (MX_TP / 2)] = (unsigned short)(x.y >> 16);
            vt[(c0 + 4) * (MX_TP / 2)] = (unsigned short)(x.z & 0xffffu); vt[(c0 + 5) * (MX_TP / 2)] = (unsigned short)(x.z >> 16); vt[(c0 + 6) * (MX_TP / 2)] = (unsigned short)(x.w & 0xffffu); vt[(c0 + 7) * (MX_TP / 2)] = (unsigned short)(x.w >> 16); }
        MX_BAR();
        f32x4 off = {0.f, 0.f, 0.f, 0.f};
#pragma unroll
        for (int s = 0; s < 15; ++s) { const f32x4 t = *(const LAS f32x4*)(L + PX_SEG + (s * 128 + 4 * cq) * 4); const float m = (s < rs) ? 1.0f : 0.0f; off += t * m; }
#pragma unroll
        for (int r = 0; r < 4; ++r) pre[r] += off;
        if (rs == 7) *(LAS f32x4*)(L + PX_RV + 16 * cq) = pre[3];
        if (rs == 15) *(LAS f32x4*)(L + PX_LV + 16 * cq) = pre[3];
        MX_BAR();
        const f32x4 Rv = *(const LAS f32x4*)(L + PX_RV + 16 * cq);
        unsigned kt[4][2];
#pragma unroll
        for (int r = 0; r < 4; ++r) { const f32x4 d = pre[r] - Rv; const int row = 4 * rs + r;
            const float q0 = bflo(qv[r].x) * fex(d.x), q1 = bfhi(qv[r].x) * fex(d.y), q2 = bflo(qv[r].y) * fex(d.z), q3 = bfhi(qv[r].y) * fex(d.w);
            const float k0 = bflo(kv[r].x) * fex(-d.x), k1 = bfhi(kv[r].x) * fex(-d.y), k2 = bflo(kv[r].y) * fex(-d.z), k3 = bfhi(kv[r].y) * fex(-d.w);
            v2u qo; qo.x = pk2(q0, q1); qo.y = pk2(q2, q3); kt[r][0] = pk2(k0, k1); kt[r][1] = pk2(k2, k3); v2u ko; ko.x = kt[r][0]; ko.y = kt[r][1];
            *(LAS v2u*)(L + PX_QT + row * MX_QP + 8 * cq) = qo; *(LAS v2u*)(L + PX_KT + row * MX_QP + 8 * cq) = ko; }
        { v2u t0_; t0_.x = (kt[0][0] & 0xffffu) | (kt[1][0] << 16); t0_.y = (kt[2][0] & 0xffffu) | (kt[3][0] << 16);
          v2u t1_; t1_.x = (kt[0][0] >> 16) | (kt[1][0] & 0xffff0000u); t1_.y = (kt[2][0] >> 16) | (kt[3][0] & 0xffff0000u);
          v2u t2_; t2_.x = (kt[0][1] & 0xffffu) | (kt[1][1] << 16); t2_.y = (kt[2][1] & 0xffffu) | (kt[3][1] << 16);
          v2u t3_; t3_.x = (kt[0][1] >> 16) | (kt[1][1] & 0xffff0000u); t3_.y = (kt[2][1] >> 16) | (kt[3][1] & 0xffff0000u);
          *(LAS v2u*)(L + PX_KTT + (4 * cq + 0) * MX_TP + 8 * rs) = t0_; *(LAS v2u*)(L + PX_KTT + (4 * cq + 1) * MX_TP + 8 * rs) = t1_;
          *(LAS v2u*)(L + PX_KTT + (4 * cq + 2) * MX_TP + 8 * rs) = t2_; *(LAS v2u*)(L + PX_KTT + (4 * cq + 3) * MX_TP + 8 * rs) = t3_; }
        MX_BAR();
        if (it + F.G < NITEM_H + NITEM_G) PX_LOAD(it + F.G);
        const int ti = w >> 1;
#pragma unroll
        for (int t2 = 0; t2 < 2; ++t2) { const int tj = 2 * (w & 1) + t2; f32x4 acc = {0.f, 0.f, 0.f, 0.f};
            if (tj <= ti) {
#pragma unroll
                for (int s = 0; s < 4; ++s) { const bf16x8 a = *(const LAS bf16x8*)(L + PX_KT + (16 * tj + n) * MX_QP + 64 * s + 16 * q4); const bf16x8 bb = *(const LAS bf16x8*)(L + PX_QT + (16 * ti + n) * MX_QP + 64 * s + 16 * q4);
                    acc = __builtin_amdgcn_mfma_f32_16x16x32_bf16(a, bb, acc, 0, 0, 0); } }
            const int i = 16 * ti + n, jj = 16 * tj + 4 * q4;
            const float p0 = (jj + 0 <= i) ? acc[0] : 0.f, p1 = (jj + 1 <= i) ? acc[1] : 0.f, p2 = (jj + 2 <= i) ? acc[2] : 0.f, p3 = (jj + 3 <= i) ? acc[3] : 0.f;
            v2u po; po.x = pk2(p0, p1); po.y = pk2(p2, p3);
            *(LAS v2u*)(L + PX_PM + i * MX_TP + 2 * jj) = po; }
        MX_BAR();
        for (int i = tid; i < 17408 / 16; i += NWAVES * 64) *(GAS v4u*)(imq + IM_QT + 16 * i) = *(const LAS v4u*)(L + PX_QT + 16 * i);
        for (int i = tid; i < 18432 / 16; i += NWAVES * 64) *(GAS v4u*)(imq + IM_KTT + 16 * i) = *(const LAS v4u*)(L + PX_KTT + 16 * i);
        for (int i = tid; i < 9216 / 16; i += NWAVES * 64) *(GAS v4u*)(imq + IM_PM + 16 * i) = *(const LAS v4u*)(L + PX_PM + 16 * i);
        if (tid < 64) *(GAS v4u*)(imq + IM_RV + 16 * tid) = *(const LAS v4u*)(L + PX_RV + 16 * tid);
        for (int i = tid; i < (hg ? VT_H : VT_G) / 16; i += NWAVES * 64) *(GAS v4u*)(imv + 16 * i) = *(const LAS v4u*)(L + PX_VT + 16 * i);
        MX_BAR();
    }
#undef PX_LOAD
}

constexpr int SQ_VT = IM_BYTES, SQ_BUF = IM_BYTES + 5120, SQ_SPT = 3 * SQ_BUF, SQ_END = SQ_SPT + 32 * MX_QP;
static_assert(SQ_END <= LDSCTL_OFF && PX_END <= LDSCTL_OFF, "mixer LDS");
__device__ __forceinline__ void mixseq_unit(Frame& F, const unsigned char* imq0, const unsigned char* imv0, int vtstride, bf16* Op, int tok0) {
    LAS unsigned char* L = F.lds + RING_OFF;
    const unsigned lbase = (unsigned)(size_t)L;
    const int lane = F.lane, w = F.wave, n = lane & 15, q4 = lane >> 4, ti = w >> 1, tv2 = w & 1;
    f32x4 S0 = {0.f, 0.f, 0.f, 0.f}, S1 = {0.f, 0.f, 0.f, 0.f};
#define SQ_DMA(c, buf) do { const unsigned char* iq_ = imq0 + (size_t)(c) * IM_BYTES; const unsigned char* iv_ = imv0 + (size_t)(c) * vtstride; \
        _Pragma("unroll") for (int k_ = 0; k_ < 7; ++k_) { const int p_ = w + 8 * k_; if (p_ < 50) { \
            const unsigned char* src_ = p_ < 45 ? iq_ + p_ * 1024 : iv_ + (p_ - 45) * 1024; \
            pg8::glds16_s((const char*)src_, (unsigned)lane * 16u, lbase + (unsigned)((buf) * SQ_BUF + p_ * 1024)); } } } while (0)
    SQ_DMA(0, 0); SQ_DMA(1, 1);
    int cb = 0;
    for (int c = 0; c < SEQ / 64; ++c) {
        const int bo = cb * SQ_BUF;
        if (c + 1 < SEQ / 64) asm volatile("s_waitcnt vmcnt(6)" ::: "memory"); else asm volatile("s_waitcnt vmcnt(0)" ::: "memory");
        MX_BAR();
        { const int nb = cb == 0 ? 2 : cb - 1;
          if (c + 2 < SEQ / 64) SQ_DMA(c + 2, nb); }
        const f32x4 Rd = *(const LAS f32x4*)(L + bo + IM_RV + 4 * (16 * w + 4 * q4)), Ld = *(const LAS f32x4*)(L + bo + IM_LV + 4 * (16 * w + 4 * q4));
        { const f32x4 eR = {fex(Rd.x), fex(Rd.y), fex(Rd.z), fex(Rd.w)};
          const f32x4 a = S0 * eR, b = S1 * eR; v2u o0, o1; o0.x = pk2(a.x, a.y); o0.y = pk2(a.z, a.w); o1.x = pk2(b.x, b.y); o1.y = pk2(b.z, b.w);
          *(LAS v2u*)(L + SQ_SPT + n * MX_QP + 2 * (16 * w + 4 * q4)) = o0; *(LAS v2u*)(L + SQ_SPT + (n + 16) * MX_QP + 2 * (16 * w + 4 * q4)) = o1; }
        f32x4 u0 = {0.f, 0.f, 0.f, 0.f}, u1 = {0.f, 0.f, 0.f, 0.f};
#pragma unroll
        for (int s = 0; s < 2; ++s) { const bf16x8 a = *(const LAS bf16x8*)(L + bo + IM_KTT + (16 * w + n) * MX_TP + 64 * s + 16 * q4);
            const bf16x8 b0 = *(const LAS bf16x8*)(L + bo + SQ_VT + n * MX_TP + 64 * s + 16 * q4), b1 = *(const LAS bf16x8*)(L + bo + SQ_VT + (16 + n) * MX_TP + 64 * s + 16 * q4);
            u0 = __builtin_amdgcn_mfma_f32_16x16x32_bf16(a, b0, u0, 0, 0, 0); u1 = __builtin_amdgcn_mfma_f32_16x16x32_bf16(a, b1, u1, 0, 0, 0); }
        { const f32x4 eG = {fex(Ld.x), fex(Ld.y), fex(Ld.z), fex(Ld.w)}; const f32x4 eL = {fex(Ld.x - Rd.x), fex(Ld.y - Rd.y), fex(Ld.z - Rd.z), fex(Ld.w - Rd.w)};
          S0 = S0 * eG + u0 * eL; S1 = S1 * eG + u1 * eL; }
        MX_BAR();
        { f32x4 acc = {0.f, 0.f, 0.f, 0.f};
#pragma unroll
          for (int s = 0; s < 2; ++s) { const bf16x8 a = *(const LAS bf16x8*)(L + bo + SQ_VT + (16 * tv2 + n) * MX_TP + 64 * s + 16 * q4); const bf16x8 b = *(const LAS bf16x8*)(L + bo + IM_PM + (16 * ti + n) * MX_TP + 64 * s + 16 * q4);
              acc = __builtin_amdgcn_mfma_f32_16x16x32_bf16(a, b, acc, 0, 0, 0); }
#pragma unroll
          for (int s = 0; s < 4; ++s) { const bf16x8 a = *(const LAS bf16x8*)(L + SQ_SPT + (16 * tv2 + n) * MX_QP + 64 * s + 16 * q4); const bf16x8 b = *(const LAS bf16x8*)(L + bo + IM_QT + (16 * ti + n) * MX_QP + 64 * s + 16 * q4);
              acc = __builtin_amdgcn_mfma_f32_16x16x32_bf16(a, b, acc, 0, 0, 0); }
          v2u ob; ob.x = pk2(acc[0], acc[1]); ob.y = pk2(acc[2], acc[3]);
          *(GAS v2u*)(Op + (size_t)(tok0 + c * 64 + 16 * ti + n) * D + 16 * tv2 + 4 * q4) = ob; }
        cb = cb == 2 ? 0 : cb + 1;
    }
#undef SQ_DMA
}
__device__ __forceinline__ void mixseq_phase(Frame& F) {
    unsigned char* A = F.ws + WS_A;
    for (int u = F.vcu; u < 256; u += F.G) {
        const bool hg = u < 128; const int u2 = hg ? u : u - 128, b = u2 >> 5;
        const int h = hg ? ((u2 & 31) >> 2) : ((u2 & 31) >> 3), vs = hg ? (u2 & 3) : (u2 & 7);
        const int item0 = hg ? (b * 8 + h) * 64 : NITEM_H + (b * 4 + h) * 64;
        const unsigned char* imq0 = F.ws + WS_XS + (size_t)item0 * IM_BYTES;
        const unsigned char* imv0 = F.ws + WS_MIXV + (hg ? (size_t)(item0) * VT_H : (size_t)NITEM_H * VT_H + (size_t)(item0 - NITEM_H) * VT_G) + (size_t)vs * (32 * MX_TP);
        bf16* Op = (bf16*)(A + A_ORAW) + (hg ? h * 128 : 1024 + h * 256) + vs * 32;
        mixseq_unit(F, imq0, imv0, hg ? VT_H : VT_G, Op, b * SEQ);
        asm volatile("s_waitcnt vmcnt(0)" ::: "memory"); __syncthreads();
    }
}


#define EN_LIST(X) X(P0) X(NORM1) X(INPROJ) X(PP) X(MIX) X(POST) X(OUT) X(NORM2) X(FUP) X(FDN) X(NORM3) X(SCAT) X(MUP) X(MDN) X(COMB) X(PLE) X(FIN)
#ifndef EN_DEFAULT
#define EN_DEFAULT 1
#endif
#ifndef EN_P0
#define EN_P0 EN_DEFAULT
#endif
#ifndef EN_NORM1
#define EN_NORM1 EN_DEFAULT
#endif
#ifndef EN_INPROJ
#define EN_INPROJ EN_DEFAULT
#endif
#ifndef EN_PP
#define EN_PP EN_DEFAULT
#endif
#ifndef EN_MIX
#define EN_MIX EN_DEFAULT
#endif
#ifndef EN_POST
#define EN_POST EN_DEFAULT
#endif
#ifndef EN_OUT
#define EN_OUT EN_DEFAULT
#endif
#ifndef EN_NORM2
#define EN_NORM2 EN_DEFAULT
#endif
#ifndef EN_FUP
#define EN_FUP EN_DEFAULT
#endif
#ifndef EN_FDN
#define EN_FDN EN_DEFAULT
#endif
#ifndef EN_NORM3
#define EN_NORM3 EN_DEFAULT
#endif
#ifndef EN_SCAT
#define EN_SCAT EN_DEFAULT
#endif
#ifndef EN_MUP
#define EN_MUP EN_DEFAULT
#endif
#ifndef EN_MDN
#define EN_MDN EN_DEFAULT
#endif
#ifndef EN_COMB
#define EN_COMB EN_DEFAULT
#endif
#ifndef EN_PLE
#define EN_PLE EN_DEFAULT
#endif
#ifndef EN_FIN
#define EN_FIN EN_DEFAULT
#endif
__global__ void __launch_bounds__(NWAVES * 64, 2) hymba_fwd(Args args) {
    extern __shared__ __attribute__((aligned(16))) unsigned char lds[];
    Frame F;
    F.lds = (LAS unsigned char*)lds;
    F.MISC = (volatile LAS unsigned*)(F.lds + MISC_OFF);
    F.G = gridDim.x; { const int bx = blockIdx.x; F.vcu = (F.G % 8 == 0) ? (bx % 8) * (F.G / 8) + bx / 8 : bx; }
#define ENTER() KArgs ka = kargs(); { int t_ = threadIdx.x; asm volatile("" : "+v"(t_)); F.tid = t_; F.lane = t_ & 63; F.wave = __builtin_amdgcn_readfirstlane(t_ >> 6); } \
    unsigned char* ws = ka->ws; F.ws = ws; F.ctl = (gu32*)(ws + WS_CTL); bf16* HN = (bf16*)(ws + WS_HN); unsigned char* A = ws + WS_A; float* H = ka->out; (void)HN; (void)A; (void)H
    int lo, hi;
    { ENTER();
      for (int u = F.tid; u < (LDS_BYTES - LDSCTL_OFF) / 4; u += NWAVES * 64) ((LAS unsigned*)(F.lds + LDSCTL_OFF))[u] = 0u;
      lo = ka->ph_lo; hi = ka->ph_hi; }
    __syncthreads();
    XcdBarrier bar; bar.bar = nullptr; bar.x = 0; bar.st = nullptr;
    if (N_LAUNCHES == 1) { ENTER(); bar = xcd_barrier_post((unsigned*)(F.ctl + CW_BAR), F.MISC + 8); }
#define GRID_BAR() do { if (N_LAUNCHES == 1) xcd_barrier(bar); } while (0)
#define IN(k) (lo <= (k) && (k) < hi)
#define BOTH(k) (IN(k) && IN((k) + 1))

    if (IN(0)) { ENTER(); if (EN_NORM1) norm_phase<false>(F, ka->in[0], ka->in[2], HN); if (EN_P0) p0_prologue(F, ka);
#ifdef PROBE_DUP_P0
        __syncthreads(); p0_prologue(F, ka);
#endif
        if (BOTH(0)) GRID_BAR(); }

    for (int l = 0; l < 2; ++l) {
        const int pb = 1 + 12 * l;
        if (IN(pb + 1)) {
            if (EN_INPROJ) { ENTER(); const int rb_ = l == 0 ? 0 : prep_rstd(F, (const float*)(ws + WS_PART) + 2 * M * 32); pg8::Gemm g{HN, (const bf16*)(ws + WS_WIN) + (size_t)l * NIN * D, M, NIN, D}; pg8::StaticOrder S; S.init(M, NIN, F.G, (int)blockIdx.x);
              pg8::EpiInProj E{(bf16*)(A + A_QH), (bf16*)(A + A_KH), (bf16*)(A + A_VH), (bf16*)(A + A_GATE), (bf16*)(A + A_QG), (bf16*)(A + A_KG), (bf16*)(A + A_VG), (float*)(A + A_GH),
                                (const float*)(ws + WS_SMALL + SM_LB) + l * 1024, (const float*)(ws + WS_SMALL + SM_L1M) + l * 1024,
                                l == 0 ? nullptr : (const LAS float*)(F.lds + RSTD_OFF), rb_};
              pg8::gemm_phase<pg8::EpiInProj, pg8::StaticOrder, PG8_ALIGN, PG8_SP2>(F.lds + RING_OFF, g, S, E);
              glr_phase(F, HN, (const bf16*)(ws + WS_SMALL + SM_WGLR) + (size_t)l * 16 * D, l == 1, (float*)(ws + WS_GLR)); }
            if (EN_PP) { ENTER(); pg8::Gemm g{(const bf16*)(ws + WS_PB) + (size_t)l * M * PLE, (const bf16*)(ws + WS_WPP) + (size_t)l * D * PLE, M, D, PLE}; pg8::StaticOrder S; S.init(M, D, F.G, (int)blockIdx.x);
              pg8::EpiPlainBf16 E{(bf16*)(ws + WS_PP), D};
              pg8::gemm_phase<pg8::EpiPlainBf16, pg8::StaticOrder, PG8_ALIGN, PG8_SP2>(F.lds + RING_OFF, g, S, E); }
            if (BOTH(pb + 1)) GRID_BAR(); }
        if (IN(pb + 2)) { ENTER(); if (EN_MIX) mixpre_phase(F, ka->in[6] + (size_t)l * 16 * 512, ka->in[7] + (size_t)l * 512);
#ifdef PROBE_DUP_PRE
            mixpre_phase(F, ka->in[6] + (size_t)l * 16 * 512, ka->in[7] + (size_t)l * 512);
#endif
            if (BOTH(pb + 2)) GRID_BAR(); }
        if (IN(pb + 3)) { ENTER(); if (EN_MIX) mixseq_phase(F);
#ifdef PROBE_DUP_SEQ
            mixseq_phase(F);
#endif
            if (BOTH(pb + 3)) GRID_BAR(); }
        if (IN(pb + 4)) { ENTER(); if (EN_POST) postmix_phase(F, (const bf16*)(A + A_ORAW), (const bf16*)(A + A_GATE), ka->in[5] + l * 1024, ka->in[8] + l * 1024, (bf16*)(A + A_O)); if (BOTH(pb + 4)) GRID_BAR(); }
        if (IN(pb + 5)) { ENTER(); if (EN_OUT) { pg8::Gemm g{(const bf16*)(A + A_O), (const bf16*)(ws + WS_WOUT) + (size_t)l * D * D, M, D, D}; pg8::StaticOrder S; S.init(M, D, F.G, (int)blockIdx.x);
            pg8::EpiResid E{l == 0 ? ka->in[0] : H, H, D, 1.0f, l == 0 ? HN : nullptr, l == 0 ? (float*)(ws + WS_PART) : nullptr};
            pg8::gemm_phase<pg8::EpiResid, pg8::StaticOrder, PG8_ALIGN, PG8_SP2>(F.lds + RING_OFF, g, S, E); }
            if (BOTH(pb + 5)) GRID_BAR(); }
        if (IN(pb + 6)) { ENTER(); if (EN_NORM2 && l == 1) norm_router_phase(F, H, ka->in[10] + l * D, ka->in[14], (unsigned char*)HN);
            if (BOTH(pb + 6) && l == 1) GRID_BAR(); }
        if (l == 0) {
            if (IN(pb + 8)) { ENTER(); if (EN_FUP) { pg8::Gemm g{HN, (const bf16*)(ws + WS_WGU), M, 2 * FFN, D}; pg8::StaticOrder S; S.init(M, 2 * FFN, F.G, (int)blockIdx.x);
                const int rb_ = prep_rstd(F, (const float*)(ws + WS_PART)); pg8::EpiSwiGLU E{(bf16*)A, FFN, 1 << 20, (const LAS float*)(F.lds + RSTD_OFF), rb_};
                pg8::gemm_phase<pg8::EpiSwiGLU, pg8::StaticOrder, PG8_ALIGN, PG8_SP2>(F.lds + RING_OFF, g, S, E);
#ifdef PROBE_DUP_FUP
                pg8::gemm_phase<pg8::EpiSwiGLU, pg8::StaticOrder, PG8_ALIGN, PG8_SP2>(F.lds + RING_OFF, g, S, E);
#endif
                }
                if (BOTH(pb + 8)) GRID_BAR(); }
            if (IN(pb + 9)) { ENTER(); if (EN_FDN) { pg8::Gemm g{(const bf16*)A, (const bf16*)(ws + WS_WD), M, D, FFN}; pg8::StaticOrder S; S.init(M, D, F.G, (int)blockIdx.x);
                pg8::EpiResid E{H, H, D, 1.0f, (bf16*)(A + A_O), (float*)(ws + WS_PART) + M * 32};
                pg8::gemm_phase<pg8::EpiResid, pg8::StaticOrder, PG8_ALIGN, PG8_SP2>(F.lds + RING_OFF, g, S, E); }
                if (BOTH(pb + 9)) GRID_BAR(); }
        } else {
            if (IN(pb + 7)) { ENTER(); if (EN_SCAT) moe_scatter_phase(F, (const unsigned char*)HN, ws + WS_XS); if (BOTH(pb + 7)) GRID_BAR(); }
            if (IN(pb + 8)) { ENTER(); if (EN_MUP) { pg8::Gemm g{(const bf16*)(ws + WS_XS), (const bf16*)(ws + WS_MGU), CAP, 2 * EFF * NEXP, D / 2}; pg8::MoeOrder S; S.init((const int*)(ws + WS_SMALL + SM_PSTART), 2 * EFF / 256, F.G, (int)blockIdx.x);
                pg8::EpiSwiGLU8 E{A, EFF, 2 * EFF / 256, 1.0f / (pg8::F8_SA * pg8::F8_SWU), pg8::F8_SM};
                pg8::gemm_phase<pg8::EpiSwiGLU8, pg8::MoeOrder, PG8_ALIGN, PG8_SP2, true>(F.lds + RING_OFF, g, S, E);
#ifdef PROBE_DUP_MUP
                pg8::gemm_phase<pg8::EpiSwiGLU8, pg8::MoeOrder, PG8_ALIGN, PG8_SP2, true>(F.lds + RING_OFF, g, S, E);
#endif
                }
                if (BOTH(pb + 8)) GRID_BAR(); }
            if (IN(pb + 9)) { ENTER(); if (EN_MDN) { pg8::Gemm g{(const bf16*)A, (const bf16*)(ws + WS_MD), CAP, D * NEXP, EFF / 2}; pg8::MoeOrder S; S.init((const int*)(ws + WS_SMALL + SM_PSTART), D / 256, F.G, (int)blockIdx.x);
                pg8::EpiMoeDown E{(bf16*)(ws + WS_XS), D, D / 256, (const float*)(ws + WS_SMALL + SM_SLOTW), 1.0f / (pg8::F8_SM * pg8::F8_SWD)};
                pg8::gemm_phase<pg8::EpiMoeDown, pg8::MoeOrder, PG8_ALIGN, PG8_SP2, true>(F.lds + RING_OFF, g, S, E); }
                if (BOTH(pb + 9)) GRID_BAR(); }
            if (IN(pb + 10)) { ENTER(); if (EN_COMB) combine_norm_phase(F, H, (const bf16*)(ws + WS_XS), ka->in[18] + l * D, HN); if (BOTH(pb + 10)) GRID_BAR(); }
        }
        if (IN(pb + 11)) { ENTER(); if (EN_PLE) { pg8::StaticOrder S; S.init(M, D, F.G, (int)blockIdx.x);
            if (l == 0) { pg8::Gemm g{(const bf16*)(A + A_O), (const bf16*)(ws + WS_WPG), M, D, D};
                const int rb_ = prep_rstd(F, (const float*)(ws + WS_PART) + M * 32);
                pg8::EpiPle E{H, (const bf16*)(ws + WS_PP), D, 1.0f, (const LAS float*)(F.lds + RSTD_OFF), rb_, HN, (float*)(ws + WS_PART) + 2 * M * 32};
                pg8::gemm_phase<pg8::EpiPle, pg8::StaticOrder, PG8_ALIGN, PG8_SP2>(F.lds + RING_OFF, g, S, E); }
            else { pg8::Gemm g{HN, (const bf16*)(ws + WS_WPG + 8 * MiB), M, D, D / 2}; pg8::EpiPle E{H, (const bf16*)(ws + WS_PP), D, 1.0f / (pg8::F8_SA * pg8::F8_SWU), nullptr, 0, nullptr, nullptr};
                pg8::gemm_phase<pg8::EpiPle, pg8::StaticOrder, PG8_ALIGN, PG8_SP2, true>(F.lds + RING_OFF, g, S, E); } }
            if (BOTH(pb + 11)) GRID_BAR(); }
    }
    if (IN(25)) { ENTER(); if (EN_FIN) final_norm_phase(F, H, ka->in[21]); }
#undef IN
#undef BOTH
#undef GRID_BAR
}

extern "C" void kernel_launch(void* const* d_in, const int* in_sizes, int n_in, void* d_out, int out_size, void* d_ws, size_t ws_size, hipStream_t stream) {
    static int grid = 0;
    if (grid == 0) {
        if (n_in != 22 || in_sizes[0] != M * D || out_size != M * D || ws_size < WS_END) { fprintf(stderr, "kernel_launch: shape/workspace mismatch: n_in %d in0 %d out %d ws %zu (need %zu)\n", n_in, n_in > 0 ? in_sizes[0] : -1, out_size, ws_size, (size_t)WS_END); grid = -1; return; }
        int dev = 0, cus = 0, per_cu = 0;
        if (hipGetDevice(&dev) != hipSuccess || hipDeviceGetAttribute(&cus, hipDeviceAttributeMultiprocessorCount, dev) != hipSuccess) { fprintf(stderr, "kernel_launch: device query failed\n"); grid = -1; return; }
        if (hipFuncSetAttribute((const void*)hymba_fwd, hipFuncAttributeMaxDynamicSharedMemorySize, LDS_BYTES) != hipSuccess) { fprintf(stderr, "kernel_launch: hipFuncSetAttribute failed\n"); grid = -1; return; }
        if (hipOccupancyMaxActiveBlocksPerMultiprocessor(&per_cu, (const void*)hymba_fwd, NWAVES * 64, LDS_BYTES) != hipSuccess || per_cu < 1)
            fprintf(stderr, "kernel_launch: note: occupancy query reports %d workgroups per CU\n", per_cu);
        (void)hipGetLastError();
        grid = cus;
    }
    if (grid < 0) return;
    if (hipMemsetAsync((char*)d_ws + WS_CTL, 0, CTL_ZERO_BYTES, stream) != hipSuccess) { fprintf(stderr, "kernel_launch: memset failed\n"); return; }
    Args a{};
    for (int i = 0; i < 22; ++i) a.in[i] = (const float*)d_in[i];
    a.out = (float*)d_out; a.ws = (unsigned char*)d_ws; a.pad = 0;
#ifndef DIAG_LAST
#define DIAG_LAST (N_PHASES - 1)
#endif
    for (int li = 0; li < N_LAUNCHES && li <= DIAG_LAST; ++li) {
        a.ph_lo = (N_LAUNCHES == 1) ? 0 : li; a.ph_hi = (N_LAUNCHES == 1) ? N_PHASES : li + 1; a.li = li;
        hipLaunchKernelGGL(hymba_fwd, dim3(grid), dim3(NWAVES * 64), LDS_BYTES, stream, a);
        const hipError_t le = hipPeekAtLastError();
        if (le != hipSuccess) { fprintf(stderr, "kernel_launch: launch %d failed: %s\n", li, hipGetErrorName(le)); break; }
    }
#ifdef DIAG_DUMP_OFF
    (void)hipMemcpyAsync(d_out, (char*)d_ws + DIAG_DUMP_OFF, (size_t)DIAG_DUMP_BYTES, hipMemcpyDeviceToDevice, stream);
#endif
}
```
